# Optimizing an MI355X kernel written in HIP

```python
import math
import jax, jax.numpy as jnp
from jax import lax
import numpy as np

D_MODEL = 1024
BATCH = 8
SEQ = 2048
DEPTH = 2
DEC_BATCH = 128
DEC_SEQ = 1
PAST_LEN = 16384
PAGE_SIZE = 128

N_MIXERS = 2
N_SSD_LAYERS = (DEPTH + N_MIXERS - 1) // N_MIXERS
N_SC_LAYERS = DEPTH // N_MIXERS
SSD_EXPAND = 2
D_INNER = SSD_EXPAND * D_MODEL
SSD_HEAD_DIM = 64
SSD_HEADS = D_INNER // SSD_HEAD_DIM
SSD_GROUPS = 4
D_STATE = 128
SSD_CONV_K = 4
SSD_CONV_DIM = D_INNER + 2 * SSD_GROUPS * D_STATE
SSD_IN_DIM = D_INNER + SSD_CONV_DIM + SSD_HEADS
CHUNK = 128
SC_EXPAND = 2
D_SC = SC_EXPAND * D_MODEL
SC_CONV_K = 3
SC_IN_DIM = 4 * D_SC
EPS = 1e-5

kernel_name = "ssd_shortconv_hybrid_step"


def rmsnorm(x, w):
    xf = x.astype(jnp.float32)
    out = xf * lax.rsqrt(jnp.mean(xf * xf, axis=-1, keepdims=True) + EPS)
    return (out * w.astype(jnp.float32)).astype(x.dtype)


def grouped_rmsnorm(y, w, groups):
    b, L, d = y.shape
    yf = y.astype(jnp.float32).reshape(b, L, groups, d // groups)
    yf = yf * lax.rsqrt(jnp.mean(yf * yf, axis=-1, keepdims=True) + EPS)
    return (yf.reshape(b, L, d) * w.astype(jnp.float32)).astype(y.dtype)


def causal_dwconv(u, buf, w):
    K = w.shape[0]
    L = u.shape[1]
    ext = jnp.concatenate([buf.astype(u.dtype), u], axis=1)
    out = ext[:, 0:L] * w[0]
    for k in range(1, K):
        out = out + ext[:, k:k + L] * w[k]
    return out, ext[:, L:]


def ssd_chunked(x, dt, A, Bm, Cm, h0):
    b, L, H, P = x.shape
    G, N = Bm.shape[2], Bm.shape[3]
    E = H // G
    Q = math.gcd(L, CHUNK)
    nc = L // Q
    f32 = jnp.float32
    a_cum = jnp.cumsum((dt * A).reshape(b, nc, Q, H), axis=2)
    xd = (x.astype(f32) * dt[..., None]).reshape(b, nc, Q, G, E, P)
    Bc = Bm.astype(f32).reshape(b, nc, Q, G, N)
    Cc = Cm.astype(f32).reshape(b, nc, Q, G, N)
    causal = jnp.tril(jnp.ones((Q, Q), dtype=bool))[None, None, :, :, None]
    seg = a_cum[:, :, :, None, :] - a_cum[:, :, None, :, :]
    Lmat = jnp.exp(jnp.where(causal, seg, -jnp.inf)).reshape(b, nc, Q, Q, G, E)
    CB = jnp.einsum("bclgn,bcsgn->bclsg", Cc, Bc)
    y_diag = jnp.einsum("bclsge,bcsgep->bclgep", CB[..., None] * Lmat, xd)
    decay_to_end = jnp.exp(a_cum[:, :, -1:, :] - a_cum).reshape(b, nc, Q, G, E)
    chunk_states = jnp.einsum("bcsgn,bcsge,bcsgep->bcgepn", Bc, decay_to_end, xd).reshape(b, nc, H, P, N)
    chunk_decay = jnp.exp(a_cum[:, :, -1, :])

    def step(h, inp):
        s, d = inp
        return h * d[:, :, None, None] + s, h

    h_final, h_prev = lax.scan(step, h0.astype(f32),
                               (jnp.moveaxis(chunk_states, 1, 0), jnp.moveaxis(chunk_decay, 1, 0)))
    h_prev = jnp.moveaxis(h_prev, 0, 1).reshape(b, nc, G, E, P, N)
    y_off = jnp.einsum("bclgn,bcgepn,bclge->bclgep", Cc, h_prev,
                       jnp.exp(a_cum).reshape(b, nc, Q, G, E))
    y = (y_diag + y_off).reshape(b, L, H, P)
    return y.astype(x.dtype), h_final.astype(h0.dtype)


def ssd_mixer(h, conv_buf, ssm_state, w_in, conv_w, conv_b, dt_bias, A_log, Dskip, norm_w, w_out):
    b, L, _ = h.shape
    proj = h @ w_in
    z = proj[..., :D_INNER]
    xBC = proj[..., D_INNER:D_INNER + SSD_CONV_DIM]
    dt = proj[..., D_INNER + SSD_CONV_DIM:]
    xBC, new_buf = causal_dwconv(xBC, conv_buf, conv_w)
    xBC = jax.nn.silu(xBC + conv_b)
    xs = xBC[..., :D_INNER].reshape(b, L, SSD_HEADS, SSD_HEAD_DIM)
    Bm = xBC[..., D_INNER:D_INNER + SSD_GROUPS * D_STATE].reshape(b, L, SSD_GROUPS, D_STATE)
    Cm = xBC[..., D_INNER + SSD_GROUPS * D_STATE:].reshape(b, L, SSD_GROUPS, D_STATE)
    dt = jax.nn.softplus((dt + dt_bias).astype(jnp.float32))
    A = -jnp.exp(A_log.astype(jnp.float32))
    y, new_state = ssd_chunked(xs, dt, A, Bm, Cm, ssm_state)
    y = y + Dskip[:, None] * xs
    y = y.reshape(b, L, D_INNER) * jax.nn.silu(z)
    y = grouped_rmsnorm(y, norm_w, SSD_GROUPS)
    return y @ w_out, new_buf, new_state


def short_conv_mixer(h, buf, w_in, conv_w, w_out):
    proj = h @ w_in
    bg = proj[..., :D_SC]
    cg = proj[..., D_SC:2 * D_SC]
    xin = proj[..., 2 * D_SC:3 * D_SC]
    z = proj[..., 3 * D_SC:]
    conv, new_buf = causal_dwconv(cg * xin, buf, conv_w)
    y = bg * conv * jax.nn.silu(z)
    return y @ w_out, new_buf


def setup_inputs(seed: int = 0) -> dict:
    key = jax.random.key(seed)
    ks = jax.random.split(key, 20)
    f32 = jnp.float32
    nrm = lambda k, s, sc: jax.random.normal(k, s, f32) * sc
    dt_init = jnp.exp(jax.random.uniform(ks[9], (N_SSD_LAYERS, SSD_HEADS), f32,
                                         minval=math.log(1e-3), maxval=math.log(1e-1)))
    return {
        "x_prompt": nrm(ks[0], (BATCH, SEQ, D_MODEL), 1.0),
        "x_sample": nrm(ks[1], (DEC_BATCH, DEC_SEQ, D_MODEL), 1.0),
        "state_ssm": nrm(ks[2], (N_SSD_LAYERS, DEC_BATCH, SSD_HEADS, SSD_HEAD_DIM, D_STATE), 0.3),
        "state_ssm_conv": nrm(ks[3], (N_SSD_LAYERS, DEC_BATCH, SSD_CONV_K - 1, SSD_CONV_DIM), 1.0),
        "state_sconv": nrm(ks[4], (N_SC_LAYERS, DEC_BATCH, SC_CONV_K - 1, D_SC), 1.0),
        "norm_w": 1.0 + nrm(ks[5], (DEPTH, D_MODEL), 0.02),
        "final_norm_w": 1.0 + nrm(ks[6], (D_MODEL,), 0.02),
        "ssd_w_in": nrm(ks[7], (N_SSD_LAYERS, D_MODEL, SSD_IN_DIM), D_MODEL ** -0.5),
        "ssd_conv_w": nrm(ks[8], (N_SSD_LAYERS, SSD_CONV_K, SSD_CONV_DIM), SSD_CONV_K ** -0.5),
        "ssd_conv_b": nrm(ks[10], (N_SSD_LAYERS, SSD_CONV_DIM), 0.02),
        "ssd_dt_bias": dt_init + jnp.log(-jnp.expm1(-dt_init)),
        "ssd_A_log": jnp.log(jax.random.uniform(ks[11], (N_SSD_LAYERS, SSD_HEADS), f32, minval=1.0, maxval=16.0)),
        "ssd_D": 1.0 + nrm(ks[12], (N_SSD_LAYERS, SSD_HEADS), 0.02),
        "ssd_norm_w": 1.0 + nrm(ks[13], (N_SSD_LAYERS, D_INNER), 0.02),
        "ssd_w_out": nrm(ks[14], (N_SSD_LAYERS, D_INNER, D_MODEL), D_INNER ** -0.5),
        "sc_w_in": nrm(ks[15], (N_SC_LAYERS, D_MODEL, SC_IN_DIM), D_MODEL ** -0.5),
        "sc_conv_w": nrm(ks[16], (N_SC_LAYERS, SC_CONV_K, D_SC), SC_CONV_K ** -0.5),
        "sc_w_out": nrm(ks[17], (N_SC_LAYERS, D_SC, D_MODEL), D_SC ** -0.5),
    }


def reference(x_prompt, x_sample, state_ssm, state_ssm_conv, state_sconv, norm_w, final_norm_w,
              ssd_w_in, ssd_conv_w, ssd_conv_b, ssd_dt_bias, ssd_A_log, ssd_D, ssd_norm_w, ssd_w_out,
              sc_w_in, sc_conv_w, sc_w_out):
    bp = x_prompt.shape[0]
    dt_ = x_prompt.dtype
    yp, ys = x_prompt, x_sample
    ssm_p, conv_p, sc_p = [], [], []
    ssm_s, conv_s, sc_s = [], [], []
    for i in range(DEPTH):
        j = i // N_MIXERS
        if i % N_MIXERS == 0:
            params = (ssd_w_in[j], ssd_conv_w[j], ssd_conv_b[j], ssd_dt_bias[j], ssd_A_log[j],
                      ssd_D[j], ssd_norm_w[j], ssd_w_out[j])
            zero_buf = jnp.zeros((bp, SSD_CONV_K - 1, SSD_CONV_DIM), dt_)
            zero_h = jnp.zeros((bp, SSD_HEADS, SSD_HEAD_DIM, D_STATE), dt_)
            out_p, cb_p, h_p = ssd_mixer(rmsnorm(yp, norm_w[i]), zero_buf, zero_h, *params)
            out_s, cb_s, h_s = ssd_mixer(rmsnorm(ys, norm_w[i]), state_ssm_conv[j], state_ssm[j], *params)
            yp = yp + out_p
            ys = ys + out_s
            ssm_p.append(h_p); conv_p.append(cb_p)
            ssm_s.append(h_s); conv_s.append(cb_s)
        else:
            zero_buf = jnp.zeros((bp, SC_CONV_K - 1, D_SC), dt_)
            out_p, b_p = short_conv_mixer(rmsnorm(yp, norm_w[i]), zero_buf, sc_w_in[j], sc_conv_w[j], sc_w_out[j])
            out_s, b_s = short_conv_mixer(rmsnorm(ys, norm_w[i]), state_sconv[j], sc_w_in[j], sc_conv_w[j], sc_w_out[j])
            yp = yp + out_p
            ys = ys + out_s
            sc_p.append(b_p)
            sc_s.append(b_s)
    y_prompt = rmsnorm(yp, final_norm_w)
    y_sample = rmsnorm(ys, final_norm_w)
    new_ssm_p = jnp.stack(ssm_p)
    new_ssm_conv_p = jnp.stack(conv_p)
    new_sconv_p = jnp.stack(sc_p)
    new_ssm_s = jnp.stack(ssm_s)
    new_ssm_conv_s = jnp.stack(conv_s)
    new_sconv_s = jnp.stack(sc_s)
    return (y_prompt, y_sample, new_ssm_p, new_ssm_conv_p, new_sconv_p, new_ssm_s, new_ssm_conv_s, new_sconv_s)
```

```cpp
#include <hip/hip_runtime.h>
#include <cstdio>
#include <cstdint>
namespace pg8 {
#define PG8_LAS __attribute__((address_space(3)))
typedef unsigned short bf16_t;
typedef short bf16x8 __attribute__((ext_vector_type(8)));
typedef float f32x4 __attribute__((ext_vector_type(4)));
typedef unsigned u32x4 __attribute__((ext_vector_type(4)));
constexpr int BM = 256, BK = 64, HALF = 128, HTB = HALF * BK * 2  , STAGE_BYTES = 8 * HTB, NXCD = 8, WGM = 8;

__host__ __device__ __forceinline__ int lds_byte(int r, int c) { const int st = (r >> 4) * 2 + (c >> 5), rr = r & 15, cc = c & 31, ob = rr * 64 + cc * 2; return st * 1024 + (ob ^ (((ob >> 9) & 1) << 5)); }
__host__ __device__ __forceinline__ void stage_rc(int b, int& R, int& C) { const int st = b / 1024, sb = b % 1024, swz = sb ^ (((sb >> 9) & 1) << 5); R = (st >> 1) * 16 + swz / 64; C = (st & 1) * 32 + (swz % 64) / 2; }
__host__ __device__ __forceinline__ int perm32(int rho) { const int n = rho >> 4, i = rho & 15; return 8 * (i >> 2) + 4 * n + (i & 3); }

struct Unit { int pm, pn; };
struct Gemm { const bf16_t* A; const bf16_t* Bt; int M, N, K; };

struct StaticOrder {
    int nM, nN, nwg, G, c;
    __host__ __device__ void init(int M, int N, int G_, int c_) { nM = M / BM; nN = N / BM; nwg = nM * nN; G = G_; c = c_; }
    __host__ __device__ bool next(int i, Unit& u) const {
        const long L = (long)i * G + c; if (L >= nwg) return false;
        int wgid = (int)L; { const int q = nwg / NXCD, r = nwg % NXCD, xcd = wgid % NXCD, off = wgid / NXCD; wgid = (xcd < r ? xcd * (q + 1) : r * (q + 1) + (xcd - r) * q) + off; }
        const int nig = WGM * nN, gid = wgid / nig, fm = gid * WGM, gsz = (nM - fm) < WGM ? (nM - fm) : WGM;
        u.pm = fm + ((wgid % nig) % gsz); u.pn = (wgid % nig) / gsz; return true;
    }
    __device__ __forceinline__ void a_ready(const Unit&) const {}
    __device__ __forceinline__ void done(const Unit&) const {}
};

__device__ __forceinline__ unsigned cvt_pk_bf16(float lo, float hi) { unsigned r; asm volatile("v_cvt_pk_bf16_f32 %0, %1, %2" : "=v"(r) : "v"(lo), "v"(hi)); return r; }
typedef float f32x2 __attribute__((ext_vector_type(2)));
typedef unsigned u32x2 __attribute__((ext_vector_type(2)));
struct EpiInSsd {
    static constexpr bool PERM = true, AFTER_DRAIN = false;
    bf16_t* Z; bf16_t* XBC; float* convp;
    __device__ __forceinline__ void operator()(const f32x4 (&acc)[2][2][4][2], const Unit& u, int wr, int wc, int fr, int fq) const {
        const int row0 = u.pm * BM + wr * 64 + fr; const int colt = u.pn * BM;
        const bool isz = colt < 2048;
        bf16_t* base = isz ? Z : XBC; const int ldc = isz ? 2048 : 3072; const int col0 = (isz ? colt : colt - 2048) + wc * 32 + 8 * fq;
#pragma unroll
        for (int ai = 0; ai < 2; ++ai)
#pragma unroll
            for (int m = 0; m < 4; ++m) { bf16_t* rowp = base + (size_t)(row0 + ai * HALF + m * 16) * ldc + col0;
#pragma unroll
                for (int bj = 0; bj < 2; ++bj) { const f32x4 v0 = acc[ai][bj][m][0], v1 = acc[ai][bj][m][1];
                    u32x4 w; w.x = cvt_pk_bf16(v0[0], v0[1]); w.y = cvt_pk_bf16(v0[2], v0[3]); w.z = cvt_pk_bf16(v1[0], v1[1]); w.w = cvt_pk_bf16(v1[2], v1[3]);
                    *(u32x4*)(rowp + bj * HALF) = w; } }
        if (!isz && (u.pm & 7) == 7 && wr == 1 && fr >= 13) {
            float* dst = convp + ((size_t)(u.pm >> 3) * 3 + (fr - 13)) * 3072 + col0;
#pragma unroll
            for (int bj = 0; bj < 2; ++bj) { *(f32x4*)(dst + bj * HALF) = acc[1][bj][3][0]; *(f32x4*)(dst + bj * HALF + 4) = acc[1][bj][3][1]; }
        }
    }
};
template <bool WITH_BF16> struct EpiResid {
    static constexpr bool PERM = false, AFTER_DRAIN = true;
    const float* base; float* out; bf16_t* ob; float* ssq;
    __device__ __forceinline__ void fused(f32x4 (&acc)[2][2][4][2], const Unit& u, int wr, int wc, int fr, int fq, PG8_LAS unsigned char* lds, int wid, int lane) const {
        PG8_LAS float* P = (PG8_LAS float*)lds;
        const int col0 = u.pn * BM + wc * 32 + 4 * fq;
#pragma unroll
        for (int ai = 0; ai < 2; ++ai)
#pragma unroll
            for (int m = 0; m < 4; ++m) { const int r = ai * HALF + wr * 64 + m * 16 + fr; const size_t off = (size_t)(u.pm * BM + r) * 1024 + col0; float s = 0.f;
#pragma unroll
                for (int bj = 0; bj < 2; ++bj)
#pragma unroll
                    for (int n = 0; n < 2; ++n) { const f32x4 bs = *(const f32x4*)(base + off + bj * HALF + n * 16); const f32x4 o = bs + acc[ai][bj][m][n];
                        s += (o[0] * o[0] + o[1] * o[1]) + (o[2] * o[2] + o[3] * o[3]);
                        *(f32x4*)(out + off + bj * HALF + n * 16) = o;
                        if (WITH_BF16) { u32x2 w; w.x = cvt_pk_bf16(o[0], o[1]); w.y = cvt_pk_bf16(o[2], o[3]); *(u32x2*)(ob + off + bj * HALF + n * 16) = w; } }
                s += __shfl_xor(s, 16); s += __shfl_xor(s, 32);
                if (fq == 0) P[r * 4 + wc] = s;
                if (m & 1) asm volatile("" ::: "memory"); }
        asm volatile("s_waitcnt lgkmcnt(0)" ::: "memory"); __builtin_amdgcn_s_barrier(); asm volatile("" ::: "memory");
        if (lane < 32) { const int row = wid * 32 + lane; const f32x4 p = *(const PG8_LAS f32x4*)(P + row * 4);
            float* d = ssq + (size_t)(u.pm * BM + row) * 8;
            if (u.pn == 0) *(f32x4*)(d + 4) = (f32x4){0.f, 0.f, 0.f, 0.f};
            d[u.pn] = (p[0] + p[1]) + (p[2] + p[3]); }
        asm volatile("s_waitcnt lgkmcnt(0)" ::: "memory"); __builtin_amdgcn_s_barrier(); asm volatile("" ::: "memory");
    }
};
__device__ __forceinline__ float silu_f(float x) { return x * __builtin_amdgcn_rcpf(1.0f + __builtin_amdgcn_exp2f(-1.4426950408889634f * x)); }
struct EpiInSc {
    static constexpr bool PERM = false, AFTER_DRAIN = false;
    bf16_t* U; bf16_t* G; const float* ssq1;
    __device__ __forceinline__ void operator()(const f32x4 (&acc)[2][2][4][2], const Unit& u, int wr, int wc, int fr, int fq) const {
        const int row0 = u.pm * BM + wr * 64 + fr; const int ch0 = u.pn * 64 + wc * 16 + 4 * fq;
#pragma unroll
        for (int ai = 0; ai < 2; ++ai)
#pragma unroll
            for (int m = 0; m < 4; ++m) { const int row = row0 + ai * HALF + m * 16;
                const f32x4 q0 = *(const f32x4*)(ssq1 + (size_t)row * 8), q1 = *(const f32x4*)(ssq1 + (size_t)row * 8 + 4);
                const float rs = 1.0f / sqrtf(((q0[0] + q0[1]) + (q0[2] + q0[3]) + (q1[0] + q1[1]) + (q1[2] + q1[3])) * (1.0f / 1024.0f) + 1e-5f);
                const f32x4 bg = acc[ai][0][m][0] * rs, cg = acc[ai][0][m][1] * rs, xi = acc[ai][1][m][0] * rs, zg = acc[ai][1][m][1] * rs;
                const f32x4 uu = cg * xi; f32x4 gg;
#pragma unroll
                for (int e = 0; e < 4; ++e) gg[e] = bg[e] * silu_f(zg[e]);
                u32x2 wu, wg; wu.x = cvt_pk_bf16(uu[0], uu[1]); wu.y = cvt_pk_bf16(uu[2], uu[3]); wg.x = cvt_pk_bf16(gg[0], gg[1]); wg.y = cvt_pk_bf16(gg[2], gg[3]);
                *(u32x2*)(U + (size_t)row * 2048 + ch0) = wu; *(u32x2*)(G + (size_t)row * 2048 + ch0) = wg; }
    }
};

template <class Epi, class Sched, bool ALIGN_EPI = false, bool SP2 = false>
__device__ __forceinline__ void gemm_phase(PG8_LAS unsigned char* lds, const Gemm g, const Sched& S, const Epi& E) {
    const int tid = threadIdx.x, wid = __builtin_amdgcn_readfirstlane(tid >> 6), lane = tid & 63, wr = wid >> 2, wc = wid & 3, fr = lane & 15, fq = lane >> 4;
    const int K = g.K, nt = K / BK;
    unsigned voffA[2], voffB[2];
#pragma unroll
    for (int i = 0; i < 2; ++i) { int R, C; stage_rc(tid * 16 + i * 8192, R, C); const int Rb = Epi::PERM ? ((R & ~31) + perm32(R & 31)) : R;
        voffA[i] = (unsigned)(R * K + C) * 2u; voffB[i] = (unsigned)(Rb * K + C) * 2u; }
    const size_t kstep = (size_t)(BK * 2);
    const size_t hstep = (size_t)HALF * K * 2;
    const size_t tstep = 2 * hstep;
    const unsigned ldsw = (unsigned)wid * 1024u;
    const int aoff = lds_byte(wr * 64 + fr, fq * 8), boff = lds_byte(wc * 32 + fr, fq * 8);
#define PG8_SA(b, h) (((b) * 2 + (h)) * HTB)
#define PG8_SB(b, h) ((4 + (b) * 2 + (h)) * HTB)
#define PG8_STAGE(bufoff, gbase, voff) do { _Pragma("unroll") for (int _i = 0; _i < 2; ++_i) \
        __builtin_amdgcn_global_load_lds((const unsigned*)((const char*)(gbase) + (voff)[_i]), (PG8_LAS unsigned*)(lds + (bufoff) + ldsw + _i * 8192), 16, 0, 0); } while (0)
#define PG8_LDA(dst, b, h) do { _Pragma("unroll") for (int m = 0; m < 4; ++m) _Pragma("unroll") for (int k = 0; k < 2; ++k) dst[m][k] = *(const PG8_LAS bf16x8*)(lds + PG8_SA(b, h) + aoff + m * 2048 + k * 1024); } while (0)
#define PG8_LDB(dst, b, h) do { _Pragma("unroll") for (int n = 0; n < 2; ++n) _Pragma("unroll") for (int k = 0; k < 2; ++k) dst[n][k] = *(const PG8_LAS bf16x8*)(lds + PG8_SB(b, h) + boff + n * 2048 + k * 1024); } while (0)
#define PG8_MMA(ai, bj, At, Bt) do { __builtin_amdgcn_s_setprio(1); _Pragma("unroll") for (int m = 0; m < 4; ++m) _Pragma("unroll") for (int n = 0; n < 2; ++n) _Pragma("unroll") for (int k = 0; k < 2; ++k) \
        acc[ai][bj][m][n] = __builtin_amdgcn_mfma_f32_16x16x32_bf16(Bt[n][k], At[m][k], acc[ai][bj][m][n], 0, 0, 0); __builtin_amdgcn_s_setprio(0); } while (0)
#define PG8_WAIT_V(n) asm volatile("s_waitcnt vmcnt(" #n ")" ::: "memory")
#define PG8_WAIT_L(n) asm volatile("s_waitcnt lgkmcnt(" #n ")" ::: "memory")
#define PG8_BAR __builtin_amdgcn_s_barrier()
#define PG8_SCHED __builtin_amdgcn_sched_barrier(0)
    Unit cur, nxt; int ui = 0;
    if (!S.next(0, cur)) return;
    f32x4 acc[2][2][4][2];
#pragma unroll
    for (int a = 0; a < 2; ++a)
#pragma unroll
        for (int b = 0; b < 2; ++b)
#pragma unroll
            for (int m = 0; m < 4; ++m)
#pragma unroll
                for (int n = 0; n < 2; ++n) acc[a][b][m][n] = (f32x4){0.f, 0.f, 0.f, 0.f};
    bf16x8 At[4][2], B0[2][2], B1[2][2];
    const char* cA = (const char*)g.A + (size_t)cur.pm * tstep; const char* cB = (const char*)g.Bt + (size_t)cur.pn * tstep;
    S.a_ready(cur);
    if constexpr (SP2) {
        PG8_STAGE(PG8_SB(0, 0), cB, voffB); PG8_STAGE(PG8_SB(0, 1), cB + hstep, voffB); PG8_STAGE(PG8_SA(0, 0), cA, voffA); PG8_STAGE(PG8_SA(0, 1), cA + hstep, voffA);
        if (wr == 1) PG8_BAR;
        PG8_WAIT_V(2); PG8_BAR;
        PG8_STAGE(PG8_SB(1, 0), cB + kstep, voffB); PG8_STAGE(PG8_SA(1, 0), cA + kstep, voffA); PG8_STAGE(PG8_SB(1, 1), cB + hstep + kstep, voffB);
        PG8_WAIT_V(6); PG8_BAR;
    } else {
        PG8_STAGE(PG8_SB(0, 0), cB, voffB); PG8_STAGE(PG8_SA(0, 0), cA, voffA); PG8_STAGE(PG8_SB(0, 1), cB + hstep, voffB); PG8_STAGE(PG8_SA(0, 1), cA + hstep, voffA);
        if (wr == 1) PG8_BAR;
        PG8_WAIT_V(4); PG8_BAR;
        PG8_STAGE(PG8_SB(1, 0), cB + kstep, voffB); PG8_STAGE(PG8_SA(1, 0), cA + kstep, voffA); PG8_STAGE(PG8_SB(1, 1), cB + hstep + kstep, voffB);
        PG8_WAIT_V(6); PG8_BAR;
    }
    for (;;) {
        const bool has_next = S.next(ui + 1, nxt);
        const char* nA = has_next ? (const char*)g.A + (size_t)nxt.pm * tstep : cA; const char* nB = has_next ? (const char*)g.Bt + (size_t)nxt.pn * tstep : cB;
        for (int t = 0; t < nt; t += 2) {
            const bool last = (t == nt - 2);
            const char* a1 = cA + (size_t)(t + 1) * kstep;
            const char* a2 = last ? nA : cA + (size_t)(t + 2) * kstep; const char* b2 = last ? nB : cB + (size_t)(t + 2) * kstep;
            const char* a3 = a2 + kstep; const char* b3 = b2 + kstep;
            if (last && has_next) S.a_ready(nxt);
            if constexpr (SP2) {
            PG8_LDB(B0, 0, 0); PG8_LDB(B1, 0, 1); PG8_SCHED; PG8_LDA(At, 0, 0); PG8_STAGE(PG8_SA(1, 1), a1 + hstep, voffA);
            PG8_WAIT_V(8); PG8_WAIT_L(0); PG8_BAR; PG8_MMA(0, 0, At, B0); PG8_MMA(0, 1, At, B1); PG8_BAR; PG8_SCHED;
            PG8_LDA(At, 0, 1); PG8_STAGE(PG8_SB(0, 0), b2, voffB); PG8_STAGE(PG8_SB(0, 1), b2 + hstep, voffB); PG8_STAGE(PG8_SA(0, 0), a2, voffA);
            PG8_WAIT_V(8); PG8_WAIT_L(0); PG8_BAR; PG8_MMA(1, 0, At, B0); PG8_MMA(1, 1, At, B1); PG8_BAR; PG8_SCHED;
            PG8_LDB(B0, 1, 0); PG8_LDB(B1, 1, 1); PG8_SCHED; PG8_LDA(At, 1, 0); PG8_STAGE(PG8_SA(0, 1), a2 + hstep, voffA);
            PG8_WAIT_V(8); PG8_WAIT_L(0); PG8_BAR; PG8_MMA(0, 0, At, B0); PG8_MMA(0, 1, At, B1); PG8_BAR; PG8_SCHED;
            PG8_LDA(At, 1, 1); PG8_STAGE(PG8_SB(1, 0), b3, voffB); PG8_STAGE(PG8_SB(1, 1), b3 + hstep, voffB); PG8_STAGE(PG8_SA(1, 0), a3, voffA);
            PG8_WAIT_V(8); PG8_WAIT_L(0); PG8_BAR; PG8_MMA(1, 0, At, B0); PG8_MMA(1, 1, At, B1); PG8_BAR; PG8_SCHED;
            } else {
            PG8_LDB(B0, 0, 0); PG8_SCHED; PG8_LDA(At, 0, 0); PG8_STAGE(PG8_SA(1, 1), a1 + hstep, voffA);
            PG8_WAIT_L(8); PG8_BAR; PG8_WAIT_L(0); PG8_MMA(0, 0, At, B0); PG8_BAR; PG8_SCHED;
            PG8_LDB(B1, 0, 1); PG8_STAGE(PG8_SB(0, 0), b2, voffB);
            PG8_BAR; PG8_WAIT_L(0); PG8_MMA(0, 1, At, B1); PG8_BAR;
            PG8_LDA(At, 0, 1); PG8_STAGE(PG8_SA(0, 0), a2, voffA);
            PG8_BAR; PG8_WAIT_L(0); PG8_MMA(1, 0, At, B0); PG8_BAR; PG8_SCHED;
            PG8_STAGE(PG8_SB(0, 1), b2 + hstep, voffB);
            PG8_WAIT_V(6); PG8_BAR; PG8_MMA(1, 1, At, B1); PG8_BAR;
            PG8_LDB(B0, 1, 0); PG8_SCHED; PG8_LDA(At, 1, 0); PG8_STAGE(PG8_SA(0, 1), a2 + hstep, voffA);
            PG8_WAIT_L(8); PG8_BAR; PG8_WAIT_L(0); PG8_MMA(0, 0, At, B0); PG8_BAR; PG8_SCHED;
            PG8_LDB(B1, 1, 1); PG8_STAGE(PG8_SB(1, 0), b3, voffB);
            PG8_BAR; PG8_WAIT_L(0); PG8_MMA(0, 1, At, B1); PG8_BAR;
            PG8_LDA(At, 1, 1); PG8_STAGE(PG8_SA(1, 0), a3, voffA);
            PG8_BAR; PG8_WAIT_L(0); PG8_MMA(1, 0, At, B0); PG8_BAR; PG8_SCHED;
            PG8_STAGE(PG8_SB(1, 1), b3 + hstep, voffB);
            PG8_WAIT_V(6); PG8_BAR; PG8_MMA(1, 1, At, B1); PG8_BAR;
            }
        }
        if constexpr (ALIGN_EPI) { if (wr == 0) PG8_BAR; }
        if constexpr (!Epi::AFTER_DRAIN) { E(acc, cur, wr, wc, fr, fq); S.done(cur); }
        if (!has_next) break;
#pragma unroll
        for (int a = 0; a < 2; ++a)
#pragma unroll
            for (int b = 0; b < 2; ++b)
#pragma unroll
                for (int m = 0; m < 4; ++m)
#pragma unroll
                    for (int n = 0; n < 2; ++n) acc[a][b][m][n] = (f32x4){0.f, 0.f, 0.f, 0.f};
        cur = nxt; cA = nA; cB = nB; ++ui;
        if constexpr (ALIGN_EPI) { if (wr == 1) PG8_BAR; }
    }
    PG8_WAIT_V(0);
    if constexpr (!ALIGN_EPI) { if (wr == 0) PG8_BAR; }
    PG8_BAR;
    if constexpr (Epi::AFTER_DRAIN) { E.fused(acc, cur, wr, wc, fr, fq, lds, wid, lane); S.done(cur); }
#undef PG8_SA
#undef PG8_SB
#undef PG8_STAGE
#undef PG8_LDA
#undef PG8_LDB
#undef PG8_MMA
#undef PG8_WAIT_V
#undef PG8_WAIT_L
#undef PG8_BAR
#undef PG8_SCHED
}
}

constexpr int NWAVES = 8;
constexpr int DM = 1024, NSEQ = 8, SEQ = 2048, MP = NSEQ * SEQ, MS = 128, MT = MP + MS;
constexpr int DIN = 2048, NH = 32, NG = 4, DS = 128, CONVD = 3072, NIN0 = 5152, NZX = 5120;
constexpr int DSC = 2048, NIN1 = 8192;
constexpr float EPS = 1e-5f, LOG2E = 1.4426950408889634f;
constexpr size_t O_YP = 0, O_YS = 16777216, O_SSMP = 16908288, O_CONVP = 19005440, O_SCP = 19079168, O_SSMS = 19111936, O_CONVS = 52666368, O_SCS = 53846016, O_END = 54370304;
constexpr size_t MiB = 1u << 20;
constexpr size_t WS_CTL = 0, CTL_ZERO_BYTES = 1 * MiB;
constexpr size_t WS_W0IN = 2 * MiB, WS_W0OUT = 13 * MiB, WS_W1IN = 17 * MiB, WS_W1OUT = 33 * MiB;
constexpr size_t WS_DT = 37 * MiB, WS_SSQ = 40 * MiB, WS_SSQ1 = 43 * MiB, WS_SSQ2 = 44 * MiB;
constexpr size_t WS_XB = 46 * MiB;
constexpr size_t WS_X1 = 80 * MiB;
constexpr size_t WS_Z = 146 * MiB;
constexpr size_t WS_XBC = 212 * MiB;
constexpr size_t WS_XBCC = 310 * MiB;
constexpr size_t WS_YG = 408 * MiB;
constexpr size_t WS_END = 474 * MiB;
constexpr int CW_BAR = 4096;
constexpr int RING_BYTES = 131072, RES_OFF = 131072, RES_BYTES = 16384, MISC_OFF = RES_OFF + RES_BYTES, LDS_BYTES = MISC_OFF + 1024;

#define GAS __attribute__((address_space(1)))
#define LAS __attribute__((address_space(3)))
typedef unsigned short bf16;
typedef unsigned v4u __attribute__((ext_vector_type(4)));
typedef float f32x4 __attribute__((ext_vector_type(4)));
typedef short bf16x8 __attribute__((ext_vector_type(8)));
typedef GAS unsigned gu32;
typedef GAS unsigned long long gu64;
#define RLX_AGENT __ATOMIC_RELAXED, __HIP_MEMORY_SCOPE_AGENT
#define LDS_WAIT() asm volatile("s_waitcnt lgkmcnt(0)" ::: "memory")
#define VM_WAIT() asm volatile("s_waitcnt vmcnt(0)" ::: "memory")
__device__ __forceinline__ unsigned long long rt() { return __builtin_amdgcn_s_memrealtime(); }
__device__ __forceinline__ unsigned f2bf(float f) { unsigned u = __builtin_bit_cast(unsigned, f); return (u + 0x7fffu + ((u >> 16) & 1u)) >> 16; }
__device__ __forceinline__ unsigned pk2(float lo, float hi) { return f2bf(lo) | (f2bf(hi) << 16); }

#define XB_TMO      128
#define XB_XCNT(j)  (256  + 64 * (j))
#define XB_XSUB(j)  (1280 + 64 * (j))
#define XB_XGEN(j)  (2304 + 64 * (j))
#define XB_TOP      3328
#define XB_TOPGEN   3392
#define XCD_BAR_WORDS 3456
#define XB_SPIN_CAP (1u << 18)

__device__ __forceinline__ unsigned xb_ld(unsigned* p)              { return __hip_atomic_load(p, __ATOMIC_RELAXED, __HIP_MEMORY_SCOPE_AGENT); }
__device__ __forceinline__ unsigned xb_add(unsigned* p, unsigned v) { return __hip_atomic_fetch_add(p, v, __ATOMIC_RELAXED, __HIP_MEMORY_SCOPE_AGENT); }
__device__ __forceinline__ unsigned xb_xcc_id() { return (unsigned)__builtin_amdgcn_s_getreg((3 << 11) | 20) & 0xFu; }
#define XB_SPIN(cond, bar) do { unsigned _sp = 0; while (cond) { __builtin_amdgcn_s_sleep(1); \
    if ((++_sp & 255u) == 0u) { if (xb_ld(&(bar)[XB_TMO])) break; if (_sp > XB_SPIN_CAP) { atomicAdd(&(bar)[XB_TMO], 1u); break; } } } } while (0)

struct XcdBarrier {
    unsigned* bar; unsigned x;
    volatile LAS unsigned* st;
};

__device__ __forceinline__ XcdBarrier xcd_barrier_post(unsigned* bar, volatile LAS unsigned* st) {
    XcdBarrier b; b.bar = bar; b.x = xb_xcc_id(); b.st = st;
    if (threadIdx.x == 0) (void)xb_add(&bar[XB_XCNT(b.x)], 1u);
    return b;
}
__device__ __forceinline__ void xcd_barrier_complete(unsigned* bar, unsigned x, unsigned& nloc, unsigned& nx) {
    const unsigned G = gridDim.x * gridDim.y * gridDim.z;
    unsigned sum, cnt, mine, sp = 0u;
    for (;;) {
        sum = 0u; cnt = 0u; mine = 0u;
#pragma unroll
        for (unsigned j = 0; j < 16; ++j) { const unsigned c = xb_ld(&bar[XB_XCNT(j)]); sum += c; cnt += (c > 0u) ? 1u : 0u; mine = (j == x) ? c : mine; }
        if (sum == G) break;
        __builtin_amdgcn_s_sleep(1);
        if ((++sp & 255u) == 0u) { if (xb_ld(&bar[XB_TMO])) break; if (sp > XB_SPIN_CAP) { atomicAdd(&bar[XB_TMO], 1u); break; } }
    }
    nloc = mine > 0u ? mine : 1u; nx = cnt > 0u ? cnt : 1u;
}

__device__ __forceinline__ void xcd_barrier(const XcdBarrier& b) {
    asm volatile("s_waitcnt vmcnt(0)" ::: "memory");
    __syncthreads();
    if (threadIdx.x == 0) {
        unsigned* bar = b.bar;
        __builtin_amdgcn_s_waitcnt(0);
        unsigned nloc = b.st[0], nx = b.st[1];
        if (nloc == 0u) { xcd_barrier_complete(bar, b.x, nloc, nx); b.st[0] = nloc; b.st[1] = nx; }
        const unsigned old = xb_add(&bar[XB_XSUB(b.x)], 1u);
        const unsigned gen = old / nloc;
        if (old + 1u == (gen + 1u) * nloc) {
            __builtin_amdgcn_fence(__ATOMIC_RELEASE, "agent");
            asm volatile("s_waitcnt vmcnt(0)" ::: "memory");
            const unsigned og = xb_add(&bar[XB_TOP], 1u);
            const unsigned tg = og / nx;
            if (og + 1u == (tg + 1u) * nx) xb_add(&bar[XB_TOPGEN], 1u);
            else XB_SPIN(xb_ld(&bar[XB_TOPGEN]) == tg, bar);
            __builtin_amdgcn_fence(__ATOMIC_ACQUIRE, "agent");
            xb_add(&bar[XB_XGEN(b.x)], 1u);
            asm volatile("s_waitcnt vmcnt(0)" ::: "memory");
        } else {
            XB_SPIN(xb_ld(&bar[XB_XGEN(b.x)]) == gen, bar);
            __builtin_amdgcn_fence(__ATOMIC_ACQUIRE, "agent");
            asm volatile("s_waitcnt vmcnt(0)" ::: "memory");
        }
    }
    __syncthreads();
}

typedef float f32x16 __attribute__((ext_vector_type(16)));
typedef unsigned u32x2 __attribute__((ext_vector_type(2)));
struct Frame {
    LAS unsigned char* lds;
    int tid, lane, wave, vcu, G;
    const float* in[18]; float* out; unsigned char* ws;
};
#define WSP(T, off) ((T*)(F.ws + (off)))
__device__ __forceinline__ float bf2f(unsigned h) { return __uint_as_float(h << 16); }
__device__ __forceinline__ float bflo(unsigned w) { return __uint_as_float(w << 16); }
__device__ __forceinline__ float bfhi(unsigned w) { return __uint_as_float(w & 0xffff0000u); }
__device__ __forceinline__ unsigned pkbf(float lo, float hi) { return pg8::cvt_pk_bf16(lo, hi); }
__device__ __forceinline__ float silu(float x) { return x * __builtin_amdgcn_rcpf(1.0f + __builtin_amdgcn_exp2f(-LOG2E * x)); }
__device__ __forceinline__ float softplus(float x) { return x > 20.f ? x : log1pf(__expf(x)); }
__device__ __forceinline__ float wave_sum(float v) {
#pragma unroll
    for (int o = 1; o < 64; o <<= 1) v += __shfl_xor(v, o);
    return v;
}
#define BAR() do { asm volatile("s_waitcnt vmcnt(0) lgkmcnt(0)" ::: "memory"); __builtin_amdgcn_s_barrier(); asm volatile("" ::: "memory"); } while (0)
__device__ __forceinline__ void unpack8(const v4u w, float (&f)[8]) {
    f[0] = bflo(w.x); f[1] = bfhi(w.x); f[2] = bflo(w.y); f[3] = bfhi(w.y); f[4] = bflo(w.z); f[5] = bfhi(w.z); f[6] = bflo(w.w); f[7] = bfhi(w.w);
}
__device__ __forceinline__ v4u pack8(const float (&f)[8]) { v4u w; w.x = pkbf(f[0], f[1]); w.y = pkbf(f[2], f[3]); w.z = pkbf(f[4], f[5]); w.w = pkbf(f[6], f[7]); return w; }

template <int MODE>
__device__ __forceinline__ void p0_transpose_item(const float* W, int K, int N, const float* scale, bf16* WT, LAS float* scr, int item, int lane) {
    const int nblk = N / 32, kb = item / nblk, nb = item % nblk, k0 = 64 * kb, n0 = 32 * nb;
#pragma unroll 8
    for (int i = 0; i < 32; ++i) { const int kk = 2 * i + (lane >> 5); const float sc = scale ? scale[k0 + kk] : 1.0f; scr[kk * 33 + (lane & 31)] = W[(size_t)(k0 + kk) * N + n0 + (lane & 31)] * sc; }
    LDS_WAIT(); asm volatile("" ::: "memory");
    const int c = lane & 7;
#pragma unroll
    for (int j = 0; j < 4; ++j) { const int n = (lane >> 3) + 8 * j; const LAS float* s = scr + (8 * c) * 33 + n;
        v4u o; o.x = pk2(s[0 * 33], s[1 * 33]); o.y = pk2(s[2 * 33], s[3 * 33]); o.z = pk2(s[4 * 33], s[5 * 33]); o.w = pk2(s[6 * 33], s[7 * 33]);
        int dr = n0 + n;
        if (MODE == 1) { const int sct = dr >> 11, ch = dr & 2047, pn = ch >> 6, chl = ch & 63; dr = pn * 256 + (sct >> 1) * 128 + (chl >> 4) * 32 + (sct & 1) * 16 + (chl & 15); }
        *(GAS v4u*)(WT + (size_t)dr * K + k0 + 8 * c) = o; }
    LDS_WAIT(); asm volatile("" ::: "memory");
}
__device__ __forceinline__ void p0_row(const float* xrow, bf16* orow, int lane) {
    const GAS f32x4* xr = (const GAS f32x4*)xrow + lane;
    f32x4 v[4]; float s = 0.f;
#pragma unroll
    for (int j = 0; j < 4; ++j) { v[j] = xr[64 * j]; s += (v[j].x * v[j].x + v[j].y * v[j].y) + (v[j].z * v[j].z + v[j].w * v[j].w); }
    const float rstd = 1.f / sqrtf(wave_sum(s) * (1.f / DM) + EPS);
    GAS u32x2* o8 = (GAS u32x2*)orow + lane;
#pragma unroll
    for (int j = 0; j < 4; ++j) { u32x2 w; w.x = pkbf(v[j].x * rstd, v[j].y * rstd); w.y = pkbf(v[j].z * rstd, v[j].w * rstd); o8[64 * j] = w; }
}
__device__ __forceinline__ void p0_prologue(Frame& F) {
    LAS float* scr = (LAS float*)(F.lds + F.wave * 16384);
    const int gw = F.vcu * NWAVES + F.wave, NGW = F.G * NWAVES;
    constexpr int I_0I = (DM / 64) * (NIN0 / 32), I_0O = (DIN / 64) * (DM / 32), I_1I = (DM / 64) * (NIN1 / 32), I_1O = (DSC / 64) * (DM / 32);
    constexpr int NITEMS = I_0I + I_0O + I_1I + I_1O;
    for (int it = gw; it < NITEMS; it += NGW) {
        int r = it;
        if (r < I_0I) { p0_transpose_item<0>(F.in[7], DM, NIN0, F.in[5], WSP(bf16, WS_W0IN), scr, r, F.lane); continue; } r -= I_0I;
        if (r < I_0O) { p0_transpose_item<0>(F.in[14], DIN, DM, F.in[13], WSP(bf16, WS_W0OUT), scr, r, F.lane); continue; } r -= I_0O;
        if (r < I_1I) { p0_transpose_item<1>(F.in[15], DM, NIN1, F.in[5] + DM, WSP(bf16, WS_W1IN), scr, r, F.lane); continue; } r -= I_1I;
        p0_transpose_item<0>(F.in[17], DSC, DM, nullptr, WSP(bf16, WS_W1OUT), scr, r, F.lane);
    }
    bf16* XB = WSP(bf16, WS_XB);
    for (int m = gw; m < MT; m += NGW) p0_row(m < MP ? F.in[0] + (size_t)m * DM : F.in[1] + (size_t)(m - MP) * DM, XB + (size_t)m * DM, F.lane);
}

struct SgRows { int a[4]; int b[4]; };
template <int RT, int CT>
__device__ __forceinline__ void sg_compute(Frame& F, const bf16* A, const bf16* Bt, int K, const SgRows R) {
    const int lane = F.lane, wid = F.wave, r32 = lane & 31, hh = lane >> 5;
    const int kw = K >> 3, k0 = wid * kw + 8 * hh, nks = kw >> 4;
    f32x16 acc[RT][CT];
#pragma unroll
    for (int i = 0; i < RT; ++i)
#pragma unroll
        for (int j = 0; j < CT; ++j)
#pragma unroll
            for (int e = 0; e < 16; ++e) acc[i][j][e] = 0.f;
    const GAS bf16x8* ap[RT]; const GAS bf16x8* bp[CT];
#pragma unroll
    for (int i = 0; i < RT; ++i) ap[i] = (const GAS bf16x8*)(A + (size_t)(R.a[i] + r32) * K + k0);
#pragma unroll
    for (int j = 0; j < CT; ++j) bp[j] = (const GAS bf16x8*)(Bt + (size_t)(R.b[j] + r32) * K + k0);
#pragma unroll 2
    for (int ks = 0; ks < nks; ++ks) {
        bf16x8 a[RT], b[CT];
#pragma unroll
        for (int i = 0; i < RT; ++i) a[i] = ap[i][2 * ks];
#pragma unroll
        for (int j = 0; j < CT; ++j) b[j] = bp[j][2 * ks];
#pragma unroll
        for (int i = 0; i < RT; ++i)
#pragma unroll
            for (int j = 0; j < CT; ++j) acc[i][j] = __builtin_amdgcn_mfma_f32_32x32x16_bf16(a[i], b[j], acc[i][j], 0, 0, 0);
    }
    LAS float* part = (LAS float*)(F.lds + wid * 16384);
#pragma unroll
    for (int i = 0; i < RT; ++i)
#pragma unroll
        for (int j = 0; j < CT; ++j)
#pragma unroll
            for (int e = 0; e < 16; ++e) part[(i * CT + j) * 1024 + e * 64 + lane] = acc[i][j][e];
    BAR();
    {
        const int t = F.tid >> 7, rr = (F.tid & 127) >> 2, cseg = F.tid & 3;
        const int reg = (rr & 3) + 4 * (rr >> 3), h2 = (rr >> 2) & 1;
        const int off = t * 1024 + reg * 64 + 32 * h2 + 8 * cseg;
        f32x4 s0 = {0.f, 0.f, 0.f, 0.f}, s1 = {0.f, 0.f, 0.f, 0.f};
#pragma unroll
        for (int w = 0; w < 8; ++w) { const LAS float* p = (const LAS float*)(F.lds + w * 16384) + off; s0 += *(const LAS f32x4*)p; s1 += *(const LAS f32x4*)(p + 4); }
        LAS float* res = (LAS float*)(F.lds + RES_OFF) + t * 1024 + rr * 32 + 8 * cseg;
        *(LAS f32x4*)res = s0; *(LAS f32x4*)(res + 4) = s1;
    }
    BAR();
}
__device__ __forceinline__ void sg_load8(Frame& F, int t, int rr, int c0, float (&v)[8]) {
    const LAS float* res = (const LAS float*)(F.lds + RES_OFF) + t * 1024 + rr * 32 + c0;
    const f32x4 a = *(const LAS f32x4*)res, b = *(const LAS f32x4*)(res + 4);
    v[0] = a[0]; v[1] = a[1]; v[2] = a[2]; v[3] = a[3]; v[4] = b[0]; v[5] = b[1]; v[6] = b[2]; v[7] = b[3];
}
__device__ __forceinline__ void p1_small(Frame& F) {
    const bf16* XB = WSP(bf16, WS_XB); const bf16* W = WSP(bf16, WS_W0IN);
    float* DT = WSP(float, WS_DT); const float* dt_bias = F.in[10];
    for (int u = F.vcu; u < 128 + 161; u += F.G) {
        SgRows R; int row_base, col_base;
        if (u < 128) { row_base = 128 * u; col_base = NZX; } else { row_base = MP; col_base = 32 * (u - 128); }
#pragma unroll
        for (int i = 0; i < 4; ++i) { R.a[i] = row_base + 32 * i; R.b[i] = col_base; }
        sg_compute<4, 1>(F, XB, W, DM, R);
        const int t = F.tid >> 7, rr = (F.tid & 127) >> 2, cseg = F.tid & 3;
        float v[8]; sg_load8(F, t, rr, 8 * cseg, v);
        const int row = row_base + 32 * t + rr, col = col_base + 8 * cseg;
        if (col >= NZX) {
#pragma unroll
            for (int e = 0; e < 8; ++e) v[e] = softplus(v[e] + dt_bias[col - NZX + e]);
            float* d = DT + (size_t)row * 32 + (col - NZX);
            *(f32x4*)d = (f32x4){v[0], v[1], v[2], v[3]}; *(f32x4*)(d + 4) = (f32x4){v[4], v[5], v[6], v[7]};
        } else if (col < DIN) {
            *(GAS v4u*)(WSP(bf16, WS_Z) + (size_t)row * DIN + col) = pack8(v);
        } else {
            *(GAS v4u*)(WSP(bf16, WS_XBC) + (size_t)row * CONVD + (col - DIN)) = pack8(v);
            float* d = F.out + O_CONVS + ((size_t)(row - MP) * 3 + 2) * CONVD + (col - DIN);
            *(f32x4*)d = (f32x4){v[0], v[1], v[2], v[3]}; *(f32x4*)(d + 4) = (f32x4){v[4], v[5], v[6], v[7]};
        }
    }
}
__device__ __forceinline__ void sample_outproj(Frame& F, const bf16* A, const bf16* Wt, const float* base, float* out, bf16* ob, float* ssq) {
    for (int u = F.vcu; u < 32; u += F.G) {
        const int i = u >> 3, q = u & 7; SgRows R;
#pragma unroll
        for (int j = 0; j < 4; ++j) { R.a[j] = MP + 32 * i; R.b[j] = 128 * q + 32 * j; }
        sg_compute<1, 4>(F, A, Wt, DIN, R);
        const int rr = F.tid >> 4, c8 = F.tid & 15;
        float v[8]; sg_load8(F, c8 >> 2, rr, 8 * (c8 & 3), v);
        const int bs = 32 * i + rr, col = 128 * q + 8 * c8;
        const f32x4 b0 = *(const f32x4*)(base + (size_t)bs * DM + col), b1 = *(const f32x4*)(base + (size_t)bs * DM + col + 4);
        float s = 0.f;
#pragma unroll
        for (int e = 0; e < 8; ++e) { v[e] += (e < 4 ? b0[e] : b1[e - 4]); s += v[e] * v[e]; }
        *(f32x4*)(out + (size_t)bs * DM + col) = (f32x4){v[0], v[1], v[2], v[3]}; *(f32x4*)(out + (size_t)bs * DM + col + 4) = (f32x4){v[4], v[5], v[6], v[7]};
        if (ob) *(GAS v4u*)(ob + (size_t)bs * DM + col) = pack8(v);
        s += __shfl_xor(s, 1); s += __shfl_xor(s, 2); s += __shfl_xor(s, 4); s += __shfl_xor(s, 8);
        if (c8 == 0) ssq[(size_t)(MP + bs) * 8 + q] = s;
    }
}
__device__ __forceinline__ void p6_small(Frame& F) {
    const bf16* X1B = WSP(bf16, WS_XB); const bf16* W = WSP(bf16, WS_W1IN); const float* ssq1 = WSP(float, WS_SSQ1);
    bf16* U = WSP(bf16, WS_Z); bf16* Gt = WSP(bf16, WS_XBCC);
    for (int u = F.vcu; u < 256; u += F.G) {
        const int i2 = u >> 7, pn = (u >> 2) & 31, wc = u & 3; SgRows R;
        R.a[0] = MP + 64 * i2; R.a[1] = MP + 64 * i2 + 32; R.a[2] = 0; R.a[3] = 0;
        R.b[0] = 256 * pn + 32 * wc; R.b[1] = 256 * pn + 128 + 32 * wc; R.b[2] = 0; R.b[3] = 0;
        sg_compute<2, 2>(F, X1B, W, DM, R);
        if (F.tid < 256) {
            const int i = F.tid >> 7, rr = (F.tid >> 2) & 31, cq = F.tid & 3;
            const LAS float* res = (const LAS float*)(F.lds + RES_OFF);
            const f32x4 bg = *(const LAS f32x4*)(res + (i * 2 + 0) * 1024 + rr * 32 + 4 * cq), cg = *(const LAS f32x4*)(res + (i * 2 + 0) * 1024 + rr * 32 + 16 + 4 * cq);
            const f32x4 xi = *(const LAS f32x4*)(res + (i * 2 + 1) * 1024 + rr * 32 + 4 * cq), zg = *(const LAS f32x4*)(res + (i * 2 + 1) * 1024 + rr * 32 + 16 + 4 * cq);
            const int bs = 64 * i2 + 32 * i + rr, row = MP + bs, ch = 64 * pn + 16 * wc + 4 * cq;
            const f32x4 q0 = *(const f32x4*)(ssq1 + (size_t)row * 8), q1 = *(const f32x4*)(ssq1 + (size_t)row * 8 + 4);
            const float rs = 1.0f / sqrtf(((q0[0] + q0[1]) + (q0[2] + q0[3]) + (q1[0] + q1[1]) + (q1[2] + q1[3])) * (1.0f / DM) + EPS);
            f32x4 uu, gg;
#pragma unroll
            for (int e = 0; e < 4; ++e) { uu[e] = (cg[e] * rs) * (xi[e] * rs); gg[e] = (bg[e] * rs) * silu(zg[e] * rs); }
            u32x2 wu, wg; wu.x = pkbf(uu[0], uu[1]); wu.y = pkbf(uu[2], uu[3]); wg.x = pkbf(gg[0], gg[1]); wg.y = pkbf(gg[2], gg[3]);
            *(GAS u32x2*)(U + (size_t)row * DSC + ch) = wu; *(GAS u32x2*)(Gt + (size_t)row * DSC + ch) = wg;
            *(f32x4*)(F.out + O_SCS + ((size_t)bs * 2 + 1) * DSC + ch) = uu;
        }
    }
}

__device__ __forceinline__ void p2_conv(Frame& F) {
    const bf16* XBC = WSP(bf16, WS_XBC); bf16* XC = WSP(bf16, WS_XBCC);
    const float* cw = F.in[8]; const float* cb = F.in[9];
    const int gt = F.vcu * (NWAVES * 64) + F.tid, NT = F.G * NWAVES * 64;
    constexpr int NCS = CONVD / 8, NP = (MP / 16) * NCS, NS = MS * NCS;
    for (int idx = gt; idx < NP + NS; idx += NT) {
        const bool smp = idx >= NP; const int id2 = smp ? idx - NP : idx;
        const int tb = id2 / NCS, c0 = (id2 % NCS) * 8;
        float w[4][8], bias[8];
#pragma unroll
        for (int k = 0; k < 4; ++k) { const f32x4 a = *(const f32x4*)(cw + k * CONVD + c0), b = *(const f32x4*)(cw + k * CONVD + c0 + 4);
#pragma unroll
            for (int e = 0; e < 4; ++e) { w[k][e] = a[e]; w[k][4 + e] = b[e]; } }
        { const f32x4 a = *(const f32x4*)(cb + c0), b = *(const f32x4*)(cb + c0 + 4);
#pragma unroll
            for (int e = 0; e < 4; ++e) { bias[e] = a[e]; bias[4 + e] = b[e]; } }
        float r0[8], r1[8], r2[8], cur[8], o[8];
        if (!smp) {
            const int tok0 = tb * 16;
            if ((tok0 & (SEQ - 1)) == 0) {
#pragma unroll
                for (int e = 0; e < 8; ++e) { r0[e] = 0.f; r1[e] = 0.f; r2[e] = 0.f; }
            } else {
                unpack8(*(const GAS v4u*)(XBC + (size_t)(tok0 - 3) * CONVD + c0), r0); unpack8(*(const GAS v4u*)(XBC + (size_t)(tok0 - 2) * CONVD + c0), r1); unpack8(*(const GAS v4u*)(XBC + (size_t)(tok0 - 1) * CONVD + c0), r2);
            }
#pragma unroll 4
            for (int t = 0; t < 16; ++t) {
                unpack8(*(const GAS v4u*)(XBC + (size_t)(tok0 + t) * CONVD + c0), cur);
#pragma unroll
                for (int e = 0; e < 8; ++e) { o[e] = silu(bias[e] + w[0][e] * r0[e] + w[1][e] * r1[e] + w[2][e] * r2[e] + w[3][e] * cur[e]); r0[e] = r1[e]; r1[e] = r2[e]; r2[e] = cur[e]; }
                *(GAS v4u*)(XC + (size_t)(tok0 + t) * CONVD + c0) = pack8(o);
            }
        } else {
            const int bs = tb; const float* st = F.in[3] + (size_t)bs * 3 * CONVD + c0; float* so = F.out + O_CONVS + (size_t)bs * 3 * CONVD + c0;
#pragma unroll
            for (int e = 0; e < 8; ++e) { r0[e] = st[e]; r1[e] = st[CONVD + e]; r2[e] = st[2 * CONVD + e]; }
            unpack8(*(const GAS v4u*)(XBC + (size_t)(MP + bs) * CONVD + c0), cur);
#pragma unroll
            for (int e = 0; e < 8; ++e) { o[e] = silu(bias[e] + w[0][e] * r0[e] + w[1][e] * r1[e] + w[2][e] * r2[e] + w[3][e] * cur[e]); so[e] = r1[e]; so[CONVD + e] = r2[e]; }
            *(GAS v4u*)(XC + (size_t)(MP + bs) * CONVD + c0) = pack8(o);
        }
    }
}

__device__ __forceinline__ int swz(int row, int col) { return row * 256 + ((((col >> 3) ^ (row & 15)) << 4) | ((col & 7) << 1)); }
__device__ __forceinline__ bf16x8 ldfrag(const LAS unsigned char* base, int row, int chunk) { return *(const LAS bf16x8*)(base + row * 256 + ((chunk ^ (row & 15)) << 4)); }
__device__ __forceinline__ void p3_ssd(Frame& F) {
    constexpr int L_C = 0, L_B = 32768, L_BDT = 65536, L_XT = 98304, L_H = 114688, L_SM = RES_OFF;
    const int tid = F.tid, lane = F.lane, wid = F.wave, r32 = lane & 31, hh = lane >> 5;
    LAS unsigned char* L = F.lds; LAS float* sm = (LAS float*)(L + L_SM);
    const bf16* XC = WSP(bf16, WS_XBCC); const bf16* Zb = WSP(bf16, WS_Z); const float* DT = WSP(float, WS_DT);
    bf16* YG = WSP(bf16, WS_YG); float* SSQ = WSP(float, WS_SSQ);
    for (int item = F.vcu; item < NSEQ * NH; item += F.G) {
        const int b = item >> 5, h = item & 31, g = h >> 3;
        const float Ah = -__expf(F.in[11][h]), Dh = F.in[12][h];
        f32x16 H;
#pragma unroll
        for (int e = 0; e < 16; ++e) H[e] = 0.f;
        const int lt = wid >> 1, pt = wid & 1, pt2 = wid >> 2, nt = wid & 3;
        const int st_a = wid < 4 ? 0 : (wid < 7 ? 1 : 2), lt_a = wid < 4 ? wid : (wid < 7 ? wid - 3 : 2);
        const int st_b = wid == 0 ? 2 : 3, lt_b = 3;
        for (int c = 0; c < SEQ / 128; ++c) {
            const int t0 = b * SEQ + c * 128;
            if (wid < 2) {
                const float dtv = DT[(size_t)(t0 + tid) * 32 + h];
                float v = dtv * Ah;
#pragma unroll
                for (int o = 1; o < 64; o <<= 1) { const float u = __shfl_up(v, o); if (lane >= o) v += u; }
                if (wid == 1) { const float a0 = DT[(size_t)(t0 + lane) * 32 + h] * Ah; v += wave_sum(a0); }
                const float a2 = v * LOG2E;
                sm[tid] = a2; sm[128 + tid] = __log2f(dtv) - a2; sm[384 + tid] = __builtin_amdgcn_exp2f(a2); sm[512 + tid] = dtv;
            }
            v4u bq[4];
#pragma unroll
            for (int i = 0; i < 4; ++i) { const int q = tid + 512 * i, row = q >> 4, ch = q & 15; const bf16* src = XC + (size_t)(t0 + row) * CONVD;
                const v4u cv = *(const GAS v4u*)(src + 2560 + 128 * g + 8 * ch); bq[i] = *(const GAS v4u*)(src + 2048 + 128 * g + 8 * ch);
                *(LAS v4u*)(L + L_C + row * 256 + ((ch ^ (row & 15)) << 4)) = cv; *(LAS v4u*)(L + L_B + row * 256 + ((ch ^ (row & 15)) << 4)) = bq[i]; }
#pragma unroll
            for (int i = 0; i < 2; ++i) { const int q = tid + 512 * i, s = q >> 3, p0 = (q & 7) * 8;
                const v4u xv = *(const GAS v4u*)(XC + (size_t)(t0 + s) * CONVD + 64 * h + p0);
#pragma unroll
                for (int j = 0; j < 8; ++j) { const unsigned w = j < 2 ? xv.x : (j < 4 ? xv.y : (j < 6 ? xv.z : xv.w)); const unsigned short hw = (unsigned short)((j & 1) ? (w >> 16) : (w & 0xffffu));
                    *(LAS unsigned short*)(L + L_XT + swz(p0 + j, s)) = hw; } }
            BAR();
            const float a2last = sm[127];
#pragma unroll
            for (int i = 0; i < 4; ++i) { const int q = tid + 512 * i, s = q >> 4, n0 = (q & 15) * 8;
                const float wsc = sm[512 + s] * __builtin_amdgcn_exp2f(a2last - sm[s]);
                float f[8]; unpack8(bq[i], f);
#pragma unroll
                for (int j = 0; j < 8; ++j) *(LAS unsigned short*)(L + L_BDT + swz(n0 + j, s)) = (unsigned short)f2bf(f[j] * wsc); }
            BAR();
            f32x16 cba, cbb, Y;
#pragma unroll
            for (int e = 0; e < 16; ++e) { cba[e] = 0.f; cbb[e] = 0.f; Y[e] = 0.f; }
#pragma unroll
            for (int ks = 0; ks < 8; ++ks) cba = __builtin_amdgcn_mfma_f32_32x32x16_bf16(ldfrag(L + L_B, 32 * st_a + r32, 2 * ks + hh), ldfrag(L + L_C, 32 * lt_a + r32, 2 * ks + hh), cba, 0, 0, 0);
            if (wid < 2) {
#pragma unroll
                for (int ks = 0; ks < 8; ++ks) cbb = __builtin_amdgcn_mfma_f32_32x32x16_bf16(ldfrag(L + L_B, 32 * st_b + r32, 2 * ks + hh), ldfrag(L + L_C, 32 * lt_b + r32, 2 * ks + hh), cbb, 0, 0, 0);
            }
            if (c > 0) {
#pragma unroll
                for (int ks = 0; ks < 8; ++ks) Y = __builtin_amdgcn_mfma_f32_32x32x16_bf16(ldfrag(L + L_C, 32 * lt + r32, 2 * ks + hh), ldfrag(L + L_H, 32 * pt + r32, 2 * ks + hh), Y, 0, 0, 0);
#pragma unroll
                for (int e = 0; e < 16; ++e) Y[e] *= sm[384 + 32 * lt + (e & 3) + 8 * (e >> 2) + 4 * hh];
            }
            BAR();
            {
                const int l = 32 * lt_a + r32; const float a2l = sm[l];
#pragma unroll
                for (int q4 = 0; q4 < 4; ++q4) { const int s0 = 32 * st_a + 8 * q4 + 4 * hh; float m[4];
#pragma unroll
                    for (int e = 0; e < 4; ++e) { const int s = s0 + e; m[e] = (s <= l) ? cba[4 * q4 + e] * __builtin_amdgcn_exp2f(a2l + sm[128 + s]) : 0.f; }
                    u32x2 w; w.x = pkbf(m[0], m[1]); w.y = pkbf(m[2], m[3]); *(LAS u32x2*)(L + L_B + swz(l, s0)) = w; }
            }
            if (wid < 2) {
                const int l = 32 * lt_b + r32; const float a2l = sm[l];
#pragma unroll
                for (int q4 = 0; q4 < 4; ++q4) { const int s0 = 32 * st_b + 8 * q4 + 4 * hh; float m[4];
#pragma unroll
                    for (int e = 0; e < 4; ++e) { const int s = s0 + e; m[e] = (s <= l) ? cbb[4 * q4 + e] * __builtin_amdgcn_exp2f(a2l + sm[128 + s]) : 0.f; }
                    u32x2 w; w.x = pkbf(m[0], m[1]); w.y = pkbf(m[2], m[3]); *(LAS u32x2*)(L + L_B + swz(l, s0)) = w; }
            }
            BAR();
            for (int s2 = 0; s2 <= lt; ++s2) {
#pragma unroll
                for (int k2 = 0; k2 < 2; ++k2) Y = __builtin_amdgcn_mfma_f32_32x32x16_bf16(ldfrag(L + L_B, 32 * lt + r32, 4 * s2 + 2 * k2 + hh), ldfrag(L + L_XT, 32 * pt + r32, 4 * s2 + 2 * k2 + hh), Y, 0, 0, 0);
            }
            { const float el = __builtin_amdgcn_exp2f(a2last);
#pragma unroll
                for (int e = 0; e < 16; ++e) H[e] *= el; }
#pragma unroll
            for (int ks = 0; ks < 8; ++ks) H = __builtin_amdgcn_mfma_f32_32x32x16_bf16(ldfrag(L + L_XT, 32 * pt2 + r32, 2 * ks + hh), ldfrag(L + L_BDT, 32 * nt + r32, 2 * ks + hh), H, 0, 0, 0);
            BAR();
#pragma unroll
            for (int e = 0; e < 16; ++e) { const int l = 32 * lt + (e & 3) + 8 * (e >> 2) + 4 * hh; *(LAS float*)(L + L_B + (l * 64 + 32 * pt + r32) * 4) = Y[e]; }
#pragma unroll
            for (int e = 0; e < 16; ++e) { const int p = 32 * pt2 + (e & 3) + 8 * (e >> 2) + 4 * hh; *(LAS unsigned short*)(L + L_H + swz(p, 32 * nt + r32)) = (unsigned short)f2bf(H[e]); }
            BAR();
            {
                const int l = tid >> 2, p0 = (tid & 3) * 16; const size_t tok = (size_t)(t0 + l);
                float y[16], xf[16], zf[16];
#pragma unroll
                for (int q4 = 0; q4 < 4; ++q4) { const f32x4 a = *(const LAS f32x4*)(L + L_B + (l * 64 + p0 + 4 * q4) * 4); y[4 * q4] = a[0]; y[4 * q4 + 1] = a[1]; y[4 * q4 + 2] = a[2]; y[4 * q4 + 3] = a[3]; }
                { float t8[8]; unpack8(*(const GAS v4u*)(XC + tok * CONVD + 64 * h + p0), t8);
#pragma unroll
                    for (int e = 0; e < 8; ++e) xf[e] = t8[e];
                    unpack8(*(const GAS v4u*)(XC + tok * CONVD + 64 * h + p0 + 8), t8);
#pragma unroll
                    for (int e = 0; e < 8; ++e) xf[8 + e] = t8[e];
                    unpack8(*(const GAS v4u*)(Zb + tok * DIN + 64 * h + p0), t8);
#pragma unroll
                    for (int e = 0; e < 8; ++e) zf[e] = t8[e];
                    unpack8(*(const GAS v4u*)(Zb + tok * DIN + 64 * h + p0 + 8), t8);
#pragma unroll
                    for (int e = 0; e < 8; ++e) zf[8 + e] = t8[e]; }
                float s = 0.f; float o0[8], o1[8];
#pragma unroll
                for (int e = 0; e < 16; ++e) { const float v = (y[e] + Dh * xf[e]) * silu(zf[e]); s += v * v; if (e < 8) o0[e] = v; else o1[e - 8] = v; }
                *(GAS v4u*)(YG + tok * DIN + 64 * h + p0) = pack8(o0); *(GAS v4u*)(YG + tok * DIN + 64 * h + p0 + 8) = pack8(o1);
                s += __shfl_xor(s, 1); s += __shfl_xor(s, 2);
                if ((tid & 3) == 0) SSQ[tok * 32 + h] = s;
            }
            BAR();
        }
        float* hp = F.out + O_SSMP + (size_t)(b * NH + h) * 64 * DS;
#pragma unroll
        for (int e = 0; e < 16; ++e) { const int p = 32 * pt2 + (e & 3) + 8 * (e >> 2) + 4 * hh; hp[p * DS + 32 * nt + r32] = H[e]; }
    }
}
__device__ __forceinline__ void p3_sample(Frame& F) {
    const int lane = F.lane, wid = F.wave, r32 = lane & 31, hh = lane >> 5;
    const bf16* XC = WSP(bf16, WS_XBCC); const bf16* Zb = WSP(bf16, WS_Z); const float* DT = WSP(float, WS_DT);
    bf16* YG = WSP(bf16, WS_YG); float* SSQ = WSP(float, WS_SSQ);
    LAS float* ys = (LAS float*)(F.lds + RES_OFF + 4096) + wid * 64;
    for (int item = F.vcu * NWAVES + wid; item < MS * NH; item += F.G * NWAVES) {
        const int bs = item >> 5, h = item & 31, g = h >> 3; const size_t row = (size_t)(MP + bs);
        const float dtv = DT[row * 32 + h], dA = __expf(dtv * -__expf(F.in[11][h])), Dh = F.in[12][h];
        const float xv = bf2f(XC[row * CONVD + 64 * h + lane]);
        const u32x2 bw = *(const GAS u32x2*)(XC + row * CONVD + 2048 + 128 * g + 4 * r32), cw = *(const GAS u32x2*)(XC + row * CONVD + 2560 + 128 * g + 4 * r32);
        const f32x4 B4 = {bflo(bw.x), bfhi(bw.x), bflo(bw.y), bfhi(bw.y)}, C4 = {bflo(cw.x), bfhi(cw.x), bflo(cw.y), bfhi(cw.y)};
        const float* hin = F.in[2] + ((size_t)bs * NH + h) * 64 * DS; float* hout = F.out + O_SSMS + ((size_t)bs * NH + h) * 64 * DS;
#pragma unroll 8
        for (int it = 0; it < 32; ++it) {
            const int p = 2 * it + hh; const float xp = __shfl(xv, p) * dtv;
            const f32x4 hv = *(const GAS f32x4*)(hin + p * DS + 4 * r32);
            const f32x4 hn = hv * dA + B4 * xp;
            *(GAS f32x4*)(hout + p * DS + 4 * r32) = hn;
            float part = (hn[0] * C4[0] + hn[1] * C4[1]) + (hn[2] * C4[2] + hn[3] * C4[3]);
            part += __shfl_xor(part, 1); part += __shfl_xor(part, 2); part += __shfl_xor(part, 4); part += __shfl_xor(part, 8); part += __shfl_xor(part, 16);
            if (r32 == 0) ys[p] = part;
        }
        LDS_WAIT(); asm volatile("" ::: "memory");
        const float yv = ys[lane];
        const float z = bf2f(Zb[row * DIN + 64 * h + lane]);
        const float yg = (yv + Dh * xv) * silu(z);
        const float s = wave_sum(yg * yg);
        YG[row * DIN + 64 * h + lane] = (bf16)f2bf(yg);
        if (lane == 0) SSQ[row * 32 + h] = s;
        LDS_WAIT(); asm volatile("" ::: "memory");
    }
}

__device__ __forceinline__ void p4_gnorm(Frame& F) {
    const bf16* YG = WSP(bf16, WS_YG); const float* SSQ = WSP(float, WS_SSQ); bf16* YN = WSP(bf16, WS_XBC);
    const int gt = F.vcu * (NWAVES * 64) + F.tid, NT = F.G * NWAVES * 64;
    for (int idx = gt; idx < MT * (DIN / 8); idx += NT) {
        const int row = idx >> 8, c0 = (idx & 255) * 8, g = c0 >> 9;
        const f32x4 q0 = *(const f32x4*)(SSQ + (size_t)row * 32 + 8 * g), q1 = *(const f32x4*)(SSQ + (size_t)row * 32 + 8 * g + 4);
        const float rs = 1.0f / sqrtf(((q0[0] + q0[1]) + (q0[2] + q0[3]) + (q1[0] + q1[1]) + (q1[2] + q1[3])) * (1.0f / 512.0f) + EPS);
        float f[8]; unpack8(*(const GAS v4u*)(YG + (size_t)row * DIN + c0), f);
#pragma unroll
        for (int e = 0; e < 8; ++e) f[e] *= rs;
        *(GAS v4u*)(YN + (size_t)row * DIN + c0) = pack8(f);
    }
}
__device__ __forceinline__ void p7_scconv(Frame& F) {
    const bf16* U = WSP(bf16, WS_Z); bf16* Gt = WSP(bf16, WS_XBCC); const float* cw = F.in[16];
    const int gt = F.vcu * (NWAVES * 64) + F.tid, NT = F.G * NWAVES * 64;
    constexpr int NCS = DSC / 8, NP = (MP / 16) * NCS, NS = MS * NCS;
    for (int idx = gt; idx < NP + NS; idx += NT) {
        const bool smp = idx >= NP; const int id2 = smp ? idx - NP : idx;
        const int tb = id2 / NCS, c0 = (id2 % NCS) * 8;
        float w[3][8];
#pragma unroll
        for (int k = 0; k < 3; ++k) { const f32x4 a = *(const f32x4*)(cw + k * DSC + c0), b = *(const f32x4*)(cw + k * DSC + c0 + 4);
#pragma unroll
            for (int e = 0; e < 4; ++e) { w[k][e] = a[e]; w[k][4 + e] = b[e]; } }
        float r0[8], r1[8], cur[8], gv[8], o[8];
        if (!smp) {
            const int tok0 = tb * 16, pos0 = tok0 & (SEQ - 1);
            if (pos0 == 0) {
#pragma unroll
                for (int e = 0; e < 8; ++e) { r0[e] = 0.f; r1[e] = 0.f; }
            } else { unpack8(*(const GAS v4u*)(U + (size_t)(tok0 - 2) * DSC + c0), r0); unpack8(*(const GAS v4u*)(U + (size_t)(tok0 - 1) * DSC + c0), r1); }
#pragma unroll 4
            for (int t = 0; t < 16; ++t) {
                unpack8(*(const GAS v4u*)(U + (size_t)(tok0 + t) * DSC + c0), cur); unpack8(*(const GAS v4u*)(Gt + (size_t)(tok0 + t) * DSC + c0), gv);
#pragma unroll
                for (int e = 0; e < 8; ++e) { o[e] = gv[e] * (w[0][e] * r0[e] + w[1][e] * r1[e] + w[2][e] * cur[e]); r0[e] = r1[e]; r1[e] = cur[e]; }
                *(GAS v4u*)(Gt + (size_t)(tok0 + t) * DSC + c0) = pack8(o);
            }
            if (pos0 == SEQ - 16) { float* d = F.out + O_SCP + (size_t)(tok0 >> 11) * 2 * DSC + c0;
#pragma unroll
                for (int e = 0; e < 8; ++e) { d[e] = r0[e]; d[DSC + e] = r1[e]; } }
        } else {
            const int bs = tb; const float* st = F.in[4] + (size_t)bs * 2 * DSC + c0;
#pragma unroll
            for (int e = 0; e < 8; ++e) { r0[e] = st[e]; r1[e] = st[DSC + e]; }
            unpack8(*(const GAS v4u*)(U + (size_t)(MP + bs) * DSC + c0), cur); unpack8(*(const GAS v4u*)(Gt + (size_t)(MP + bs) * DSC + c0), gv);
            float* so = F.out + O_SCS + (size_t)bs * 2 * DSC + c0;
#pragma unroll
            for (int e = 0; e < 8; ++e) { o[e] = gv[e] * (w[0][e] * r0[e] + w[1][e] * r1[e] + w[2][e] * cur[e]); so[e] = r1[e]; }
            *(GAS v4u*)(Gt + (size_t)(MP + bs) * DSC + c0) = pack8(o);
        }
    }
}
__device__ __forceinline__ void p9_final(Frame& F) {
    const float* ssq2 = WSP(float, WS_SSQ2); const float* fw = F.in[6];
    const int gw = F.vcu * NWAVES + F.wave, NGW = F.G * NWAVES;
    f32x4 wv[4];
#pragma unroll
    for (int j = 0; j < 4; ++j) wv[j] = *((const GAS f32x4*)fw + F.lane + 64 * j);
    for (int m = gw; m < MT; m += NGW) {
        float* rowp = m < MP ? F.out + O_YP + (size_t)m * DM : F.out + O_YS + (size_t)(m - MP) * DM;
        const f32x4 q0 = *(const f32x4*)(ssq2 + (size_t)m * 8), q1 = *(const f32x4*)(ssq2 + (size_t)m * 8 + 4);
        const float rs = 1.0f / sqrtf(((q0[0] + q0[1]) + (q0[2] + q0[3]) + (q1[0] + q1[1]) + (q1[2] + q1[3])) * (1.0f / DM) + EPS);
        GAS f32x4* xr = (GAS f32x4*)rowp + F.lane;
#pragma unroll
        for (int j = 0; j < 4; ++j) { const f32x4 v = xr[64 * j]; xr[64 * j] = v * rs * wv[j]; }
    }
}

constexpr int N_PHASES = 10;
struct Args { const float* in[18]; float* out; unsigned char* ws; int ph_lo, ph_hi, li, pad; };
__global__ void __launch_bounds__(NWAVES * 64, 2) hyb_fwd(Args args) {
    extern __shared__ __attribute__((aligned(16))) unsigned char lds[];
    Frame F;
    F.lds = (LAS unsigned char*)lds;
    F.tid = threadIdx.x; F.lane = F.tid & 63; F.wave = __builtin_amdgcn_readfirstlane(F.tid >> 6);
    F.G = gridDim.x; { const int bx = blockIdx.x; F.vcu = (F.G % 8 == 0) ? (bx % 8) * (F.G / 8) + bx / 8 : bx; }
#pragma unroll
    for (int i = 0; i < 18; ++i) F.in[i] = args.in[i];
    F.out = args.out; F.ws = args.ws;
    volatile LAS unsigned* MISC = (volatile LAS unsigned*)(F.lds + MISC_OFF);
    for (int u = F.tid; u < (LDS_BYTES - MISC_OFF) / 4; u += NWAVES * 64) ((LAS unsigned*)(F.lds + MISC_OFF))[u] = 0u;
    __syncthreads();
    const int lo = args.ph_lo, hi = args.ph_hi;
    const bool multi = (hi - lo) > 1;
    XcdBarrier bar; bar.bar = (unsigned*)(F.ws + WS_CTL) + CW_BAR; bar.x = 0; bar.st = nullptr;
    if (multi) bar = xcd_barrier_post((unsigned*)(F.ws + WS_CTL) + CW_BAR, MISC + 8);
#define IN(k) (lo <= (k) && (k) < hi)
#define SEAM(k) do { if (IN(k) && IN((k) + 1)) xcd_barrier(bar); } while (0)
    LAS unsigned char* ring = (LAS unsigned char*)F.lds;
    if (IN(0)) { p0_prologue(F); } SEAM(0);
    if (IN(1)) {
        pg8::Gemm g{WSP(pg8::bf16_t, WS_XB), WSP(pg8::bf16_t, WS_W0IN), MP, NZX, DM}; pg8::StaticOrder S; S.init(MP, NZX, F.G, (int)blockIdx.x);
        pg8::EpiInSsd E{WSP(pg8::bf16_t, WS_Z), WSP(pg8::bf16_t, WS_XBC), F.out + O_CONVP};
        pg8::gemm_phase<pg8::EpiInSsd, pg8::StaticOrder, true, true>(ring, g, S, E);
        p1_small(F);
    } SEAM(1);
    if (IN(2)) { p2_conv(F); } SEAM(2);
    if (IN(3)) { p3_ssd(F); p3_sample(F); } SEAM(3);
    if (IN(4)) { p4_gnorm(F); } SEAM(4);
    if (IN(5)) {
        pg8::Gemm g{WSP(pg8::bf16_t, WS_XBC), WSP(pg8::bf16_t, WS_W0OUT), MP, DM, DIN}; pg8::StaticOrder S; S.init(MP, DM, F.G, (int)blockIdx.x);
        pg8::EpiResid<true> E{F.in[0], WSP(float, WS_X1), WSP(pg8::bf16_t, WS_XB), WSP(float, WS_SSQ1)};
        pg8::gemm_phase<pg8::EpiResid<true>, pg8::StaticOrder, false, true>(ring, g, S, E);
        sample_outproj(F, WSP(bf16, WS_XBC), WSP(bf16, WS_W0OUT), F.in[1], WSP(float, WS_X1) + (size_t)MP * DM, WSP(bf16, WS_XB) + (size_t)MP * DM, WSP(float, WS_SSQ1));
    } SEAM(5);
    if (IN(6)) {
        pg8::Gemm g{WSP(pg8::bf16_t, WS_XB), WSP(pg8::bf16_t, WS_W1IN), MP, NIN1, DM}; pg8::StaticOrder S; S.init(MP, NIN1, F.G, (int)blockIdx.x);
        pg8::EpiInSc E{WSP(pg8::bf16_t, WS_Z), WSP(pg8::bf16_t, WS_XBCC), WSP(float, WS_SSQ1)};
        pg8::gemm_phase<pg8::EpiInSc, pg8::StaticOrder, true, true>(ring, g, S, E);
        p6_small(F);
    } SEAM(6);
    if (IN(7)) { p7_scconv(F); } SEAM(7);
    if (IN(8)) {
        pg8::Gemm g{WSP(pg8::bf16_t, WS_XBCC), WSP(pg8::bf16_t, WS_W1OUT), MP, DM, DSC}; pg8::StaticOrder S; S.init(MP, DM, F.G, (int)blockIdx.x);
        pg8::EpiResid<false> E{WSP(float, WS_X1), F.out + O_YP, nullptr, WSP(float, WS_SSQ2)};
        pg8::gemm_phase<pg8::EpiResid<false>, pg8::StaticOrder, false, true>(ring, g, S, E);
        sample_outproj(F, WSP(bf16, WS_XBCC), WSP(bf16, WS_W1OUT), WSP(float, WS_X1) + (size_t)MP * DM, F.out + O_YS, nullptr, WSP(float, WS_SSQ2));
    } SEAM(8);
    if (IN(9)) { p9_final(F); }
#undef IN
#undef SEAM
}

#ifndef HYB_N_LAUNCHES
#define HYB_N_LAUNCHES 1
#endif
extern "C" void kernel_launch(void* const* d_in, const int* in_sizes, int n_in, void* d_out, int out_size, void* d_ws, size_t ws_size, hipStream_t stream) {
    static int grid = 0;
    if (grid == 0) {
        if (n_in != 18 || in_sizes[0] != MP * DM || out_size != (int)O_END || ws_size < WS_END) { fprintf(stderr, "kernel_launch: unexpected shapes: n_in %d in0 %d out %d ws %zu\n", n_in, n_in > 0 ? in_sizes[0] : -1, out_size, ws_size); grid = -1; return; }
        int dev = 0, cus = 0, per_cu = 0;
        if (hipGetDevice(&dev) != hipSuccess || hipDeviceGetAttribute(&cus, hipDeviceAttributeMultiprocessorCount, dev) != hipSuccess) { grid = -1; return; }
        if (hipFuncSetAttribute((const void*)hyb_fwd, hipFuncAttributeMaxDynamicSharedMemorySize, LDS_BYTES) != hipSuccess) { fprintf(stderr, "kernel_launch: hipFuncSetAttribute failed\n"); grid = -1; return; }
        if (hipOccupancyMaxActiveBlocksPerMultiprocessor(&per_cu, (const void*)hyb_fwd, NWAVES * 64, LDS_BYTES) != hipSuccess || per_cu < 1) fprintf(stderr, "kernel_launch: occupancy query reports %d blocks per CU\n", per_cu);
        (void)hipGetLastError();
        grid = cus;
    }
    if (grid < 0) return;
    if (hipMemsetAsync((char*)d_ws + WS_CTL, 0, CTL_ZERO_BYTES, stream) != hipSuccess) { fprintf(stderr, "kernel_launch: memset failed\n"); return; }
    Args a{};
    for (int i = 0; i < 18; ++i) a.in[i] = (const float*)d_in[i];
    a.out = (float*)d_out; a.ws = (unsigned char*)d_ws;
    if (HYB_N_LAUNCHES == 1) { a.ph_lo = 0; a.ph_hi = N_PHASES; a.li = 0; hipLaunchKernelGGL(hyb_fwd, dim3(grid), dim3(NWAVES * 64), LDS_BYTES, stream, a); }
    else for (int p = 0; p < N_PHASES; ++p) { a.ph_lo = p; a.ph_hi = p + 1; a.li = p; hipLaunchKernelGGL(hyb_fwd, dim3(grid), dim3(NWAVES * 64), LDS_BYTES, stream, a); }
    const hipError_t le = hipPeekAtLastError();
    if (le != hipSuccess) fprintf(stderr, "kernel_launch: launch failed: %s\n", hipGetErrorName(le));
}
```

```cpp
#include <hip/hip_runtime.h>
#include <cstdio>
#include <cstdint>
namespace pg8 {
#define PG8_LAS __attribute__((address_space(3)))
typedef unsigned short bf16_t;
typedef short bf16x8 __attribute__((ext_vector_type(8)));
typedef float f32x4 __attribute__((ext_vector_type(4)));
typedef unsigned u32x4 __attribute__((ext_vector_type(4)));
constexpr int BM = 256, BK = 64, HALF = 128, HTB = HALF * BK * 2  , STAGE_BYTES = 8 * HTB, NXCD = 8, WGM = 8;

__host__ __device__ __forceinline__ int lds_byte(int r, int c) { const int st = (r >> 4) * 2 + (c >> 5), rr = r & 15, cc = c & 31, ob = rr * 64 + cc * 2; return st * 1024 + (ob ^ (((ob >> 9) & 1) << 5)); }
__host__ __device__ __forceinline__ void stage_rc(int b, int& R, int& C) { const int st = b / 1024, sb = b % 1024, swz = sb ^ (((sb >> 9) & 1) << 5); R = (st >> 1) * 16 + swz / 64; C = (st & 1) * 32 + (swz % 64) / 2; }
__host__ __device__ __forceinline__ int perm32(int rho) { const int n = rho >> 4, i = rho & 15; return 8 * (i >> 2) + 4 * n + (i & 3); }

struct Unit { int pm, pn; };
struct Gemm { const bf16_t* A; const bf16_t* Bt; int M, N, K; };

struct StaticOrder {
    int nM, nN, nwg, G, c;
    __host__ __device__ void init(int M, int N, int G_, int c_) { nM = M / BM; nN = N / BM; nwg = nM * nN; G = G_; c = c_; }
    __host__ __device__ bool next(int i, Unit& u) const {
        const long L = (long)i * G + c; if (L >= nwg) return false;
        int wgid = (int)L; { const int q = nwg / NXCD, r = nwg % NXCD, xcd = wgid % NXCD, off = wgid / NXCD; wgid = (xcd < r ? xcd * (q + 1) : r * (q + 1) + (xcd - r) * q) + off; }
        const int nig = WGM * nN, gid = wgid / nig, fm = gid * WGM, gsz = (nM - fm) < WGM ? (nM - fm) : WGM;
        u.pm = fm + ((wgid % nig) % gsz); u.pn = (wgid % nig) / gsz; return true;
    }
    __device__ __forceinline__ void a_ready(const Unit&) const {}
    __device__ __forceinline__ void done(const Unit&) const {}
};

typedef float f32x2_cv __attribute__((ext_vector_type(2))); typedef __bf16 bf16x2_cv __attribute__((ext_vector_type(2)));
__device__ __forceinline__ unsigned cvt_pk_bf16(float lo, float hi) { const f32x2_cv v = {lo, hi}; const bf16x2_cv b = __builtin_convertvector(v, bf16x2_cv); return __builtin_bit_cast(unsigned, b); }
typedef float f32x2 __attribute__((ext_vector_type(2)));
typedef unsigned u32x2 __attribute__((ext_vector_type(2)));
struct EpiInSsd {
    static constexpr bool PERM = true, AFTER_DRAIN = false;
    bf16_t* Z; bf16_t* XBC; float* convp;
    __device__ __forceinline__ void operator()(const f32x4 (&acc)[2][2][4][2], const Unit& u, int wr, int wc, int fr, int fq) const {
        const int row0 = u.pm * BM + wr * 64 + fr; const int colt = u.pn * BM;
        const bool isz = colt < 2048;
        bf16_t* base = isz ? Z : XBC; const int ldc = isz ? 2048 : 3072; const int col0 = (isz ? colt : colt - 2048) + wc * 32 + 8 * fq;
#pragma unroll
        for (int ai = 0; ai < 2; ++ai)
#pragma unroll
            for (int m = 0; m < 4; ++m) { bf16_t* rowp = base + (size_t)(row0 + ai * HALF + m * 16) * ldc + col0;
#pragma unroll
                for (int bj = 0; bj < 2; ++bj) { const f32x4 v0 = acc[ai][bj][m][0], v1 = acc[ai][bj][m][1];
                    u32x4 w; w.x = cvt_pk_bf16(v0[0], v0[1]); w.y = cvt_pk_bf16(v0[2], v0[3]); w.z = cvt_pk_bf16(v1[0], v1[1]); w.w = cvt_pk_bf16(v1[2], v1[3]);
                    *(u32x4*)(rowp + bj * HALF) = w; } }
        if (!isz && (u.pm & 7) == 7 && wr == 1 && fr >= 13) {
            float* dst = convp + ((size_t)(u.pm >> 3) * 3 + (fr - 13)) * 3072 + col0;
#pragma unroll
            for (int bj = 0; bj < 2; ++bj) { *(f32x4*)(dst + bj * HALF) = acc[1][bj][3][0]; *(f32x4*)(dst + bj * HALF + 4) = acc[1][bj][3][1]; }
        }
    }
};
template <bool WITH_BF16> struct EpiResid {
    static constexpr bool PERM = false, AFTER_DRAIN = true;
    const float* base; float* out; bf16_t* ob; float* ssq;
    __device__ __forceinline__ void fused(f32x4 (&acc)[2][2][4][2], const Unit& u, int wr, int wc, int fr, int fq, PG8_LAS unsigned char* lds, int wid, int lane) const {
        PG8_LAS float* P = (PG8_LAS float*)lds;
        const int col0 = u.pn * BM + wc * 32 + 4 * fq;
#pragma unroll
        for (int ai = 0; ai < 2; ++ai)
#pragma unroll
            for (int m = 0; m < 4; ++m) { const int r = ai * HALF + wr * 64 + m * 16 + fr; const size_t off = (size_t)(u.pm * BM + r) * 1024 + col0; float s = 0.f;
#pragma unroll
                for (int bj = 0; bj < 2; ++bj)
#pragma unroll
                    for (int n = 0; n < 2; ++n) { const f32x4 bs = *(const f32x4*)(base + off + bj * HALF + n * 16); const f32x4 o = bs + acc[ai][bj][m][n];
                        s += (o[0] * o[0] + o[1] * o[1]) + (o[2] * o[2] + o[3] * o[3]);
                        *(f32x4*)(out + off + bj * HALF + n * 16) = o;
                        if (WITH_BF16) { u32x2 w; w.x = cvt_pk_bf16(o[0], o[1]); w.y = cvt_pk_bf16(o[2], o[3]); *(u32x2*)(ob + off + bj * HALF + n * 16) = w; } }
                s += __shfl_xor(s, 16); s += __shfl_xor(s, 32);
                if (fq == 0) P[r * 4 + wc] = s;
                if (m & 1) asm volatile("" ::: "memory"); }
        asm volatile("s_waitcnt lgkmcnt(0)" ::: "memory"); __builtin_amdgcn_s_barrier(); asm volatile("" ::: "memory");
        if (lane < 32) { const int row = wid * 32 + lane; const f32x4 p = *(const PG8_LAS f32x4*)(P + row * 4);
            float* d = ssq + (size_t)(u.pm * BM + row) * 8;
            if (u.pn == 0) *(f32x4*)(d + 4) = (f32x4){0.f, 0.f, 0.f, 0.f};
            d[u.pn] = (p[0] + p[1]) + (p[2] + p[3]); }
        asm volatile("s_waitcnt lgkmcnt(0)" ::: "memory"); __builtin_amdgcn_s_barrier(); asm volatile("" ::: "memory");
    }
};
__device__ __forceinline__ float silu_f(float x) { return x * __builtin_amdgcn_rcpf(1.0f + __builtin_amdgcn_exp2f(-1.4426950408889634f * x)); }
struct EpiInSc {
    static constexpr bool PERM = false, AFTER_DRAIN = false;
    bf16_t* U; bf16_t* G; const float* ssq1;
    __device__ __forceinline__ void operator()(const f32x4 (&acc)[2][2][4][2], const Unit& u, int wr, int wc, int fr, int fq) const {
        const int row0 = u.pm * BM + wr * 64 + fr; const int ch0 = u.pn * 64 + wc * 16 + 4 * fq;
#pragma unroll
        for (int ai = 0; ai < 2; ++ai)
#pragma unroll
            for (int m = 0; m < 4; ++m) { const int row = row0 + ai * HALF + m * 16;
                const f32x4 q0 = *(const f32x4*)(ssq1 + (size_t)row * 8), q1 = *(const f32x4*)(ssq1 + (size_t)row * 8 + 4);
                const float rs = 1.0f / sqrtf(((q0[0] + q0[1]) + (q0[2] + q0[3]) + (q1[0] + q1[1]) + (q1[2] + q1[3])) * (1.0f / 1024.0f) + 1e-5f);
                const f32x4 bg = acc[ai][0][m][0] * rs, cg = acc[ai][0][m][1] * rs, xi = acc[ai][1][m][0] * rs, zg = acc[ai][1][m][1] * rs;
                const f32x4 uu = cg * xi; f32x4 gg;
#pragma unroll
                for (int e = 0; e < 4; ++e) gg[e] = bg[e] * silu_f(zg[e]);
                u32x2 wu, wg; wu.x = cvt_pk_bf16(uu[0], uu[1]); wu.y = cvt_pk_bf16(uu[2], uu[3]); wg.x = cvt_pk_bf16(gg[0], gg[1]); wg.y = cvt_pk_bf16(gg[2], gg[3]);
                *(u32x2*)(U + (size_t)row * 2048 + ch0) = wu; *(u32x2*)(G + (size_t)row * 2048 + ch0) = wg; }
    }
};

template <class Epi, class Sched, bool ALIGN_EPI = false, bool SP2 = false>
__device__ __forceinline__ void gemm_phase(PG8_LAS unsigned char* lds, const Gemm g, const Sched& S, const Epi& E) {
    const int tid = threadIdx.x, wid = __builtin_amdgcn_readfirstlane(tid >> 6), lane = tid & 63, wr = wid >> 2, wc = wid & 3, fr = lane & 15, fq = lane >> 4;
    const int K = g.K, nt = K / BK;
    unsigned voffA[2], voffB[2];
#pragma unroll
    for (int i = 0; i < 2; ++i) { int R, C; stage_rc(tid * 16 + i * 8192, R, C); const int Rb = Epi::PERM ? ((R & ~31) + perm32(R & 31)) : R;
        voffA[i] = (unsigned)(R * K + C) * 2u; voffB[i] = (unsigned)(Rb * K + C) * 2u; }
    const size_t kstep = (size_t)(BK * 2);
    const size_t hstep = (size_t)HALF * K * 2;
    const size_t tstep = 2 * hstep;
    const unsigned ldsw = (unsigned)wid * 1024u;
    const int aoff = lds_byte(wr * 64 + fr, fq * 8), boff = lds_byte(wc * 32 + fr, fq * 8);
#define PG8_SA(b, h) (((b) * 2 + (h)) * HTB)
#define PG8_SB(b, h) ((4 + (b) * 2 + (h)) * HTB)
#define PG8_STAGE(bufoff, gbase, voff) do { _Pragma("unroll") for (int _i = 0; _i < 2; ++_i) \
        __builtin_amdgcn_global_load_lds((const unsigned*)((const char*)(gbase) + (voff)[_i]), (PG8_LAS unsigned*)(lds + (bufoff) + ldsw + _i * 8192), 16, 0, 0); } while (0)
#define PG8_LDA(dst, b, h) do { _Pragma("unroll") for (int m = 0; m < 4; ++m) _Pragma("unroll") for (int k = 0; k < 2; ++k) dst[m][k] = *(const PG8_LAS bf16x8*)(lds + PG8_SA(b, h) + aoff + m * 2048 + k * 1024); } while (0)
#define PG8_LDB(dst, b, h) do { _Pragma("unroll") for (int n = 0; n < 2; ++n) _Pragma("unroll") for (int k = 0; k < 2; ++k) dst[n][k] = *(const PG8_LAS bf16x8*)(lds + PG8_SB(b, h) + boff + n * 2048 + k * 1024); } while (0)
#define PG8_MMA(ai, bj, At, Bt) do { __builtin_amdgcn_s_setprio(1); _Pragma("unroll") for (int m = 0; m < 4; ++m) _Pragma("unroll") for (int n = 0; n < 2; ++n) _Pragma("unroll") for (int k = 0; k < 2; ++k) \
        acc[ai][bj][m][n] = __builtin_amdgcn_mfma_f32_16x16x32_bf16(Bt[n][k], At[m][k], acc[ai][bj][m][n], 0, 0, 0); __builtin_amdgcn_s_setprio(0); } while (0)
#define PG8_WAIT_V(n) asm volatile("s_waitcnt vmcnt(" #n ")" ::: "memory")
#define PG8_WAIT_L(n) asm volatile("s_waitcnt lgkmcnt(" #n ")" ::: "memory")
#define PG8_BAR __builtin_amdgcn_s_barrier()
#define PG8_SCHED __builtin_amdgcn_sched_barrier(0)
    Unit cur, nxt; int ui = 0;
    if (!S.next(0, cur)) return;
    f32x4 acc[2][2][4][2];
#pragma unroll
    for (int a = 0; a < 2; ++a)
#pragma unroll
        for (int b = 0; b < 2; ++b)
#pragma unroll
            for (int m = 0; m < 4; ++m)
#pragma unroll
                for (int n = 0; n < 2; ++n) acc[a][b][m][n] = (f32x4){0.f, 0.f, 0.f, 0.f};
    bf16x8 At[4][2], B0[2][2], B1[2][2];
    const char* cA = (const char*)g.A + (size_t)cur.pm * tstep; const char* cB = (const char*)g.Bt + (size_t)cur.pn * tstep;
    S.a_ready(cur);
    if constexpr (SP2) {
        PG8_STAGE(PG8_SB(0, 0), cB, voffB); PG8_STAGE(PG8_SB(0, 1), cB + hstep, voffB); PG8_STAGE(PG8_SA(0, 0), cA, voffA); PG8_STAGE(PG8_SA(0, 1), cA + hstep, voffA);
        if (wr == 1) PG8_BAR;
        PG8_WAIT_V(2); PG8_BAR;
        PG8_STAGE(PG8_SB(1, 0), cB + kstep, voffB); PG8_STAGE(PG8_SA(1, 0), cA + kstep, voffA); PG8_STAGE(PG8_SB(1, 1), cB + hstep + kstep, voffB);
        PG8_WAIT_V(6); PG8_BAR;
    } else {
        PG8_STAGE(PG8_SB(0, 0), cB, voffB); PG8_STAGE(PG8_SA(0, 0), cA, voffA); PG8_STAGE(PG8_SB(0, 1), cB + hstep, voffB); PG8_STAGE(PG8_SA(0, 1), cA + hstep, voffA);
        if (wr == 1) PG8_BAR;
        PG8_WAIT_V(4); PG8_BAR;
        PG8_STAGE(PG8_SB(1, 0), cB + kstep, voffB); PG8_STAGE(PG8_SA(1, 0), cA + kstep, voffA); PG8_STAGE(PG8_SB(1, 1), cB + hstep + kstep, voffB);
        PG8_WAIT_V(6); PG8_BAR;
    }
    for (;;) {
        const bool has_next = S.next(ui + 1, nxt);
        const char* nA = has_next ? (const char*)g.A + (size_t)nxt.pm * tstep : cA; const char* nB = has_next ? (const char*)g.Bt + (size_t)nxt.pn * tstep : cB;
        for (int t = 0; t < nt; t += 2) {
            const bool last = (t == nt - 2);
            const char* a1 = cA + (size_t)(t + 1) * kstep;
            const char* a2 = last ? nA : cA + (size_t)(t + 2) * kstep; const char* b2 = last ? nB : cB + (size_t)(t + 2) * kstep;
            const char* a3 = a2 + kstep; const char* b3 = b2 + kstep;
            if (last && has_next) S.a_ready(nxt);
            if constexpr (SP2) {
            PG8_LDB(B0, 0, 0); PG8_LDB(B1, 0, 1); PG8_SCHED; PG8_LDA(At, 0, 0); PG8_STAGE(PG8_SA(1, 1), a1 + hstep, voffA);
            PG8_WAIT_V(8); PG8_WAIT_L(0); PG8_BAR; PG8_MMA(0, 0, At, B0); PG8_MMA(0, 1, At, B1); PG8_BAR; PG8_SCHED;
            PG8_LDA(At, 0, 1); PG8_STAGE(PG8_SB(0, 0), b2, voffB); PG8_STAGE(PG8_SB(0, 1), b2 + hstep, voffB); PG8_STAGE(PG8_SA(0, 0), a2, voffA);
            PG8_WAIT_V(8); PG8_WAIT_L(0); PG8_BAR; PG8_MMA(1, 0, At, B0); PG8_MMA(1, 1, At, B1); PG8_BAR; PG8_SCHED;
            PG8_LDB(B0, 1, 0); PG8_LDB(B1, 1, 1); PG8_SCHED; PG8_LDA(At, 1, 0); PG8_STAGE(PG8_SA(0, 1), a2 + hstep, voffA);
            PG8_WAIT_V(8); PG8_WAIT_L(0); PG8_BAR; PG8_MMA(0, 0, At, B0); PG8_MMA(0, 1, At, B1); PG8_BAR; PG8_SCHED;
            PG8_LDA(At, 1, 1); PG8_STAGE(PG8_SB(1, 0), b3, voffB); PG8_STAGE(PG8_SB(1, 1), b3 + hstep, voffB); PG8_STAGE(PG8_SA(1, 0), a3, voffA);
            PG8_WAIT_V(8); PG8_WAIT_L(0); PG8_BAR; PG8_MMA(1, 0, At, B0); PG8_MMA(1, 1, At, B1); PG8_BAR; PG8_SCHED;
            } else {
            PG8_LDB(B0, 0, 0); PG8_SCHED; PG8_LDA(At, 0, 0); PG8_STAGE(PG8_SA(1, 1), a1 + hstep, voffA);
            PG8_WAIT_L(8); PG8_BAR; PG8_WAIT_L(0); PG8_MMA(0, 0, At, B0); PG8_BAR; PG8_SCHED;
            PG8_LDB(B1, 0, 1); PG8_STAGE(PG8_SB(0, 0), b2, voffB);
            PG8_BAR; PG8_WAIT_L(0); PG8_MMA(0, 1, At, B1); PG8_BAR;
            PG8_LDA(At, 0, 1); PG8_STAGE(PG8_SA(0, 0), a2, voffA);
            PG8_BAR; PG8_WAIT_L(0); PG8_MMA(1, 0, At, B0); PG8_BAR; PG8_SCHED;
            PG8_STAGE(PG8_SB(0, 1), b2 + hstep, voffB);
            PG8_WAIT_V(6); PG8_BAR; PG8_MMA(1, 1, At, B1); PG8_BAR;
            PG8_LDB(B0, 1, 0); PG8_SCHED; PG8_LDA(At, 1, 0); PG8_STAGE(PG8_SA(0, 1), a2 + hstep, voffA);
            PG8_WAIT_L(8); PG8_BAR; PG8_WAIT_L(0); PG8_MMA(0, 0, At, B0); PG8_BAR; PG8_SCHED;
            PG8_LDB(B1, 1, 1); PG8_STAGE(PG8_SB(1, 0), b3, voffB);
            PG8_BAR; PG8_WAIT_L(0); PG8_MMA(0, 1, At, B1); PG8_BAR;
            PG8_LDA(At, 1, 1); PG8_STAGE(PG8_SA(1, 0), a3, voffA);
            PG8_BAR; PG8_WAIT_L(0); PG8_MMA(1, 0, At, B0); PG8_BAR; PG8_SCHED;
            PG8_STAGE(PG8_SB(1, 1), b3 + hstep, voffB);
            PG8_WAIT_V(6); PG8_BAR; PG8_MMA(1, 1, At, B1); PG8_BAR;
            }
        }
        if constexpr (ALIGN_EPI) { if (wr == 0) PG8_BAR; }
        if constexpr (!Epi::AFTER_DRAIN) { E(acc, cur, wr, wc, fr, fq); S.done(cur); }
        if (!has_next) break;
#pragma unroll
        for (int a = 0; a < 2; ++a)
#pragma unroll
            for (int b = 0; b < 2; ++b)
#pragma unroll
                for (int m = 0; m < 4; ++m)
#pragma unroll
                    for (int n = 0; n < 2; ++n) acc[a][b][m][n] = (f32x4){0.f, 0.f, 0.f, 0.f};
        cur = nxt; cA = nA; cB = nB; ++ui;
        if constexpr (ALIGN_EPI) { if (wr == 1) PG8_BAR; }
    }
    PG8_WAIT_V(0);
    if constexpr (!ALIGN_EPI) { if (wr == 0) PG8_BAR; }
    PG8_BAR;
    if constexpr (Epi::AFTER_DRAIN) { E.fused(acc, cur, wr, wc, fr, fq, lds, wid, lane); S.done(cur); }
#undef PG8_SA
#undef PG8_SB
#undef PG8_STAGE
#undef PG8_LDA
#undef PG8_LDB
#undef PG8_MMA
#undef PG8_WAIT_V
#undef PG8_WAIT_L
#undef PG8_BAR
#undef PG8_SCHED
}
}

constexpr int NWAVES = 8;
constexpr int DM = 1024, NSEQ = 8, SEQ = 2048, MP = NSEQ * SEQ, MS = 128, MT = MP + MS;
constexpr int DIN = 2048, NH = 32, NG = 4, DS = 128, CONVD = 3072, NIN0 = 5152, NZX = 5120;
constexpr int DSC = 2048, NIN1 = 8192;
constexpr float EPS = 1e-5f, LOG2E = 1.4426950408889634f;
constexpr size_t O_YP = 0, O_YS = 16777216, O_SSMP = 16908288, O_CONVP = 19005440, O_SCP = 19079168, O_SSMS = 19111936, O_CONVS = 52666368, O_SCS = 53846016, O_END = 54370304;
constexpr size_t MiB = 1u << 20;
constexpr size_t WS_CTL = 0, CTL_ZERO_BYTES = 1 * MiB;
constexpr size_t WS_W0IN = 2 * MiB, WS_W0OUT = 13 * MiB, WS_W1IN = 17 * MiB, WS_W1OUT = 33 * MiB;
constexpr size_t WS_DT = 37 * MiB, WS_SSQ = 40 * MiB, WS_SSQ1 = 43 * MiB, WS_SSQ2 = 44 * MiB;
constexpr size_t WS_XB = 46 * MiB;
constexpr size_t WS_X1 = 80 * MiB;
constexpr size_t WS_Z = 146 * MiB;
constexpr size_t WS_XBC = 212 * MiB;
constexpr size_t WS_XBCC = 310 * MiB;
constexpr size_t WS_YG = 408 * MiB;
constexpr size_t WS_END = 474 * MiB;
constexpr int CW_BAR = 4096;
constexpr int RING_BYTES = 131072, RES_OFF = 131072, RES_BYTES = 30208, MISC_OFF = RES_OFF + RES_BYTES, LDS_BYTES = MISC_OFF + 1024;

#define GAS __attribute__((address_space(1)))
#define LAS __attribute__((address_space(3)))
typedef unsigned short bf16;
typedef unsigned v4u __attribute__((ext_vector_type(4)));
typedef float f32x4 __attribute__((ext_vector_type(4)));
typedef short bf16x8 __attribute__((ext_vector_type(8)));
typedef GAS unsigned gu32;
typedef GAS unsigned long long gu64;
#define RLX_AGENT __ATOMIC_RELAXED, __HIP_MEMORY_SCOPE_AGENT
#define LDS_WAIT() asm volatile("s_waitcnt lgkmcnt(0)" ::: "memory")
#define VM_WAIT() asm volatile("s_waitcnt vmcnt(0)" ::: "memory")
__device__ __forceinline__ unsigned long long rt() { return __builtin_amdgcn_s_memrealtime(); }
__device__ __forceinline__ unsigned f2bf(float f) { unsigned u = __builtin_bit_cast(unsigned, f); return (u + 0x7fffu + ((u >> 16) & 1u)) >> 16; }
__device__ __forceinline__ unsigned pk2(float lo, float hi) { return f2bf(lo) | (f2bf(hi) << 16); }

#define XB_TMO      128
#define XB_XCNT(j)  (256  + 64 * (j))
#define XB_XSUB(j)  (1280 + 64 * (j))
#define XB_XGEN(j)  (2304 + 64 * (j))
#define XB_TOP      3328
#define XB_TOPGEN   3392
#define XCD_BAR_WORDS 3456
#define XB_SPIN_CAP (1u << 18)

__device__ __forceinline__ unsigned xb_ld(unsigned* p)              { return __hip_atomic_load(p, __ATOMIC_RELAXED, __HIP_MEMORY_SCOPE_AGENT); }
__device__ __forceinline__ unsigned xb_add(unsigned* p, unsigned v) { return __hip_atomic_fetch_add(p, v, __ATOMIC_RELAXED, __HIP_MEMORY_SCOPE_AGENT); }
__device__ __forceinline__ unsigned xb_xcc_id() { return (unsigned)__builtin_amdgcn_s_getreg((3 << 11) | 20) & 0xFu; }
#define XB_SPIN(cond, bar) do { unsigned _sp = 0; while (cond) { __builtin_amdgcn_s_sleep(1); \
    if ((++_sp & 255u) == 0u) { if (xb_ld(&(bar)[XB_TMO])) break; if (_sp > XB_SPIN_CAP) { atomicAdd(&(bar)[XB_TMO], 1u); break; } } } } while (0)

struct XcdBarrier {
    unsigned* bar; unsigned x;
    volatile LAS unsigned* st;
};

__device__ __forceinline__ XcdBarrier xcd_barrier_post(unsigned* bar, volatile LAS unsigned* st) {
    XcdBarrier b; b.bar = bar; b.x = xb_xcc_id(); b.st = st;
    if (threadIdx.x == 0) (void)xb_add(&bar[XB_XCNT(b.x)], 1u);
    return b;
}
__device__ __forceinline__ void xcd_barrier_complete(unsigned* bar, unsigned x, unsigned& nloc, unsigned& nx) {
    const unsigned G = gridDim.x * gridDim.y * gridDim.z;
    unsigned sum, cnt, mine, sp = 0u;
    for (;;) {
        sum = 0u; cnt = 0u; mine = 0u;
#pragma unroll
        for (unsigned j = 0; j < 16; ++j) { const unsigned c = xb_ld(&bar[XB_XCNT(j)]); sum += c; cnt += (c > 0u) ? 1u : 0u; mine = (j == x) ? c : mine; }
        if (sum == G) break;
        __builtin_amdgcn_s_sleep(1);
        if ((++sp & 255u) == 0u) { if (xb_ld(&bar[XB_TMO])) break; if (sp > XB_SPIN_CAP) { atomicAdd(&bar[XB_TMO], 1u); break; } }
    }
    nloc = mine > 0u ? mine : 1u; nx = cnt > 0u ? cnt : 1u;
}

__device__ __forceinline__ void xcd_barrier(const XcdBarrier& b) {
    asm volatile("s_waitcnt vmcnt(0)" ::: "memory");
    __syncthreads();
    if (threadIdx.x == 0) {
        unsigned* bar = b.bar;
        __builtin_amdgcn_s_waitcnt(0);
        unsigned nloc = b.st[0], nx = b.st[1];
        if (nloc == 0u) { xcd_barrier_complete(bar, b.x, nloc, nx); b.st[0] = nloc; b.st[1] = nx; }
        const unsigned old = xb_add(&bar[XB_XSUB(b.x)], 1u);
        const unsigned gen = old / nloc;
        if (old + 1u == (gen + 1u) * nloc) {
            __builtin_amdgcn_fence(__ATOMIC_RELEASE, "agent");
            asm volatile("s_waitcnt vmcnt(0)" ::: "memory");
            const unsigned og = xb_add(&bar[XB_TOP], 1u);
            const unsigned tg = og / nx;
            if (og + 1u == (tg + 1u) * nx) xb_add(&bar[XB_TOPGEN], 1u);
            else XB_SPIN(xb_ld(&bar[XB_TOPGEN]) == tg, bar);
            __builtin_amdgcn_fence(__ATOMIC_ACQUIRE, "agent");
            xb_add(&bar[XB_XGEN(b.x)], 1u);
            asm volatile("s_waitcnt vmcnt(0)" ::: "memory");
        } else {
            XB_SPIN(xb_ld(&bar[XB_XGEN(b.x)]) == gen, bar);
            __builtin_amdgcn_fence(__ATOMIC_ACQUIRE, "agent");
            asm volatile("s_waitcnt vmcnt(0)" ::: "memory");
        }
    }
    __syncthreads();
}

typedef float f32x16 __attribute__((ext_vector_type(16)));
typedef unsigned u32x2 __attribute__((ext_vector_type(2)));
struct Frame {
    LAS unsigned char* lds;
    int tid, lane, wave, vcu, G;
    const float* in[18]; float* out; unsigned char* ws;
};
#define WSP(T, off) ((T*)(F.ws + (off)))
__device__ __forceinline__ float bf2f(unsigned h) { return __uint_as_float(h << 16); }
__device__ __forceinline__ float bflo(unsigned w) { return __uint_as_float(w << 16); }
__device__ __forceinline__ float bfhi(unsigned w) { return __uint_as_float(w & 0xffff0000u); }
__device__ __forceinline__ unsigned pkbf(float lo, float hi) { return pg8::cvt_pk_bf16(lo, hi); }
__device__ __forceinline__ float silu(float x) { return x * __builtin_amdgcn_rcpf(1.0f + __builtin_amdgcn_exp2f(-LOG2E * x)); }
__device__ __forceinline__ float softplus(float x) { return x > 20.f ? x : log1pf(__expf(x)); }
__device__ __forceinline__ float wave_sum(float v) {
#pragma unroll
    for (int o = 1; o < 64; o <<= 1) v += __shfl_xor(v, o);
    return v;
}
#define BAR() do { asm volatile("s_waitcnt vmcnt(0) lgkmcnt(0)" ::: "memory"); __builtin_amdgcn_s_barrier(); asm volatile("" ::: "memory"); } while (0)
__device__ __forceinline__ void unpack8(const v4u w, float (&f)[8]) {
    f[0] = bflo(w.x); f[1] = bfhi(w.x); f[2] = bflo(w.y); f[3] = bfhi(w.y); f[4] = bflo(w.z); f[5] = bfhi(w.z); f[6] = bflo(w.w); f[7] = bfhi(w.w);
}
__device__ __forceinline__ v4u pack8(const float (&f)[8]) { v4u w; w.x = pkbf(f[0], f[1]); w.y = pkbf(f[2], f[3]); w.z = pkbf(f[4], f[5]); w.w = pkbf(f[6], f[7]); return w; }

template <int MODE>
__device__ __forceinline__ void p0_transpose_item(const float* W, int K, int N, const float* scale, bf16* WT, LAS float* scr, int item, int lane) {
    const int nblk = N / 32, kb = item / nblk, nb = item % nblk, k0 = 64 * kb, n0 = 32 * nb;
#pragma unroll 8
    for (int i = 0; i < 32; ++i) { const int kk = 2 * i + (lane >> 5); const float sc = scale ? scale[k0 + kk] : 1.0f; scr[kk * 33 + (lane & 31)] = W[(size_t)(k0 + kk) * N + n0 + (lane & 31)] * sc; }
    LDS_WAIT(); asm volatile("" ::: "memory");
    const int c = lane & 7;
#pragma unroll
    for (int j = 0; j < 4; ++j) { const int n = (lane >> 3) + 8 * j; const LAS float* s = scr + (8 * c) * 33 + n;
        v4u o; o.x = pk2(s[0 * 33], s[1 * 33]); o.y = pk2(s[2 * 33], s[3 * 33]); o.z = pk2(s[4 * 33], s[5 * 33]); o.w = pk2(s[6 * 33], s[7 * 33]);
        int dr = n0 + n;
        if (MODE == 1) { const int sct = dr >> 11, ch = dr & 2047, pn = ch >> 6, chl = ch & 63; dr = pn * 256 + (sct >> 1) * 128 + (chl >> 4) * 32 + (sct & 1) * 16 + (chl & 15); }
        *(GAS v4u*)(WT + (size_t)dr * K + k0 + 8 * c) = o; }
    LDS_WAIT(); asm volatile("" ::: "memory");
}
__device__ __forceinline__ void p0_row(const float* xrow, bf16* orow, int lane) {
    const GAS f32x4* xr = (const GAS f32x4*)xrow + lane;
    f32x4 v[4]; float s = 0.f;
#pragma unroll
    for (int j = 0; j < 4; ++j) { v[j] = xr[64 * j]; s += (v[j].x * v[j].x + v[j].y * v[j].y) + (v[j].z * v[j].z + v[j].w * v[j].w); }
    const float rstd = 1.f / sqrtf(wave_sum(s) * (1.f / DM) + EPS);
    GAS u32x2* o8 = (GAS u32x2*)orow + lane;
#pragma unroll
    for (int j = 0; j < 4; ++j) { u32x2 w; w.x = pkbf(v[j].x * rstd, v[j].y * rstd); w.y = pkbf(v[j].z * rstd, v[j].w * rstd); o8[64 * j] = w; }
}
__device__ __forceinline__ void p0_prologue(Frame& F) {
    LAS float* scr = (LAS float*)(F.lds + F.wave * 16384);
    const int gw = F.vcu * NWAVES + F.wave, NGW = F.G * NWAVES;
    constexpr int I_0I = (DM / 64) * (NIN0 / 32), I_0O = (DIN / 64) * (DM / 32), I_1I = (DM / 64) * (NIN1 / 32), I_1O = (DSC / 64) * (DM / 32);
    constexpr int NITEMS = I_0I + I_0O + I_1I + I_1O;
    for (int it = gw; it < NITEMS; it += NGW) {
        int r = it;
        if (r < I_0I) { p0_transpose_item<0>(F.in[7], DM, NIN0, F.in[5], WSP(bf16, WS_W0IN), scr, r, F.lane); continue; } r -= I_0I;
        if (r < I_0O) { p0_transpose_item<0>(F.in[14], DIN, DM, F.in[13], WSP(bf16, WS_W0OUT), scr, r, F.lane); continue; } r -= I_0O;
        if (r < I_1I) { p0_transpose_item<1>(F.in[15], DM, NIN1, F.in[5] + DM, WSP(bf16, WS_W1IN), scr, r, F.lane); continue; } r -= I_1I;
        p0_transpose_item<0>(F.in[17], DSC, DM, nullptr, WSP(bf16, WS_W1OUT), scr, r, F.lane);
    }
    bf16* XB = WSP(bf16, WS_XB);
    for (int m = gw; m < MT; m += NGW) p0_row(m < MP ? F.in[0] + (size_t)m * DM : F.in[1] + (size_t)(m - MP) * DM, XB + (size_t)m * DM, F.lane);
}

struct SgRows { int a[4]; int b[4]; };
#define LBAR() do { asm volatile("s_waitcnt lgkmcnt(0)" ::: "memory"); __builtin_amdgcn_s_barrier(); asm volatile("" ::: "memory"); } while (0)
template <int RT, int CT>
__device__ __forceinline__ void sg_compute(Frame& F, const bf16* A, const bf16* Bt, int K, const SgRows R) {
    constexpr int NG = RT + CT, NT = RT * CT, WPT = 8 / NT, KPW = 4 / WPT, NP = (NG + 1) / 2, BUFB = 20480, RED_OFF = 65536;
    static_assert(NT == 2 || NT == 4, "2 or 4 tiles per unit");
    const int tid = F.tid, lane = F.lane, wid = F.wave, r32 = lane & 31, hh = lane >> 5;
    LAS unsigned char* L = F.lds;
    const GAS v4u* src[NP]; int loff[NP]; bool act[NP];
#pragma unroll
    for (int i = 0; i < NP; ++i) { const int p = tid + 512 * i, slot = p >> 3, piece = p & 7, grp = slot >> 5; act[i] = grp < NG;
        const bf16* base = A;
#pragma unroll
        for (int g = 0; g < NG; ++g) if (grp == g) base = (g < RT) ? A + (size_t)R.a[g < RT ? g : 0] * K : Bt + (size_t)R.b[g >= RT ? g - RT : 0] * K;
        src[i] = (const GAS v4u*)(base + (size_t)(slot & 31) * K + piece * 8); loff[i] = slot * 128 + ((piece ^ (slot & 7)) << 4); }
    const int nch = K >> 6;
    v4u r0[NP], r1[NP];
#pragma unroll
    for (int i = 0; i < NP; ++i) if (act[i]) r0[i] = src[i][0];
#pragma unroll
    for (int i = 0; i < NP; ++i) if (act[i]) *(LAS v4u*)(L + loff[i]) = r0[i];
#pragma unroll
    for (int i = 0; i < NP; ++i) if (act[i]) { r0[i] = src[i][8]; r1[i] = src[i][16]; }
    LBAR();
    f32x16 acc;
#pragma unroll
    for (int e = 0; e < 16; ++e) acc[e] = 0.f;
    const int t = wid / WPT, kp = wid % WPT, arow = 32 * (t / CT) + r32, brow = 32 * (RT + t % CT) + r32;
    for (int c = 0; c < nch; ++c) {
        const int bo = (c & 1) * BUFB;
#pragma unroll
        for (int kk = 0; kk < KPW; ++kk) { const int piece = 2 * (kp * KPW + kk) + hh;
            const bf16x8 a = *(const LAS bf16x8*)(L + bo + arow * 128 + ((piece ^ (arow & 7)) << 4)), b = *(const LAS bf16x8*)(L + bo + brow * 128 + ((piece ^ (brow & 7)) << 4));
            acc = __builtin_amdgcn_mfma_f32_32x32x16_bf16(a, b, acc, 0, 0, 0); }
        if (c + 1 < nch) {
#pragma unroll
            for (int i = 0; i < NP; ++i) if (act[i]) *(LAS v4u*)(L + (bo ^ BUFB) + loff[i]) = r0[i]; }
#pragma unroll
        for (int i = 0; i < NP; ++i) r0[i] = r1[i];
        if (c + 3 < nch) {
#pragma unroll
            for (int i = 0; i < NP; ++i) if (act[i]) r1[i] = src[i][8 * (c + 3)]; }
        LBAR();
    }
    { LAS float* part = (LAS float*)(L + RED_OFF + wid * 4096);
#pragma unroll
        for (int e = 0; e < 16; ++e) part[e * 64 + lane] = acc[e]; }
    LBAR();
    if constexpr (NT == 4) {
        const int t2 = tid >> 7, rr = (tid & 127) >> 2, cseg = tid & 3;
        const int off = ((rr & 3) + 4 * (rr >> 3)) * 64 + 32 * ((rr >> 2) & 1) + 8 * cseg;
        f32x4 s0 = {0.f, 0.f, 0.f, 0.f}, s1 = {0.f, 0.f, 0.f, 0.f};
#pragma unroll
        for (int w = 0; w < WPT; ++w) { const LAS float* p = (const LAS float*)(L + RED_OFF + (t2 * WPT + w) * 4096) + off; s0 += *(const LAS f32x4*)p; s1 += *(const LAS f32x4*)(p + 4); }
        LAS float* res = (LAS float*)(L + RES_OFF) + t2 * 1024 + rr * 32 + 8 * cseg;
        *(LAS f32x4*)res = s0; *(LAS f32x4*)(res + 4) = s1;
    } else {
        const int t2 = tid >> 8, rr = (tid & 255) >> 3, c4 = (tid & 7) * 4;
        const int off = ((rr & 3) + 4 * (rr >> 3)) * 64 + 32 * ((rr >> 2) & 1) + c4;
        f32x4 s0 = {0.f, 0.f, 0.f, 0.f};
#pragma unroll
        for (int w = 0; w < WPT; ++w) s0 += *(const LAS f32x4*)((const LAS float*)(L + RED_OFF + (t2 * WPT + w) * 4096) + off);
        *(LAS f32x4*)((LAS float*)(L + RES_OFF) + t2 * 1024 + rr * 32 + c4) = s0;
    }
    LBAR();
}
__device__ __forceinline__ void sg_load8(Frame& F, int t, int rr, int c0, float (&v)[8]) {
    const LAS float* res = (const LAS float*)(F.lds + RES_OFF) + t * 1024 + rr * 32 + c0;
    const f32x4 a = *(const LAS f32x4*)res, b = *(const LAS f32x4*)(res + 4);
    v[0] = a[0]; v[1] = a[1]; v[2] = a[2]; v[3] = a[3]; v[4] = b[0]; v[5] = b[1]; v[6] = b[2]; v[7] = b[3];
}
__device__ __forceinline__ void p1_small(Frame& F) {
    const bf16* XB = WSP(bf16, WS_XB); const bf16* W = WSP(bf16, WS_W0IN);
    float* DT = WSP(float, WS_DT); const float* dt_bias = F.in[10];
    for (int u = blockIdx.x; u < 161; u += F.G) {
        SgRows R; const int row_base = MP, col_base = 32 * u;
#pragma unroll
        for (int i = 0; i < 4; ++i) { R.a[i] = row_base + 32 * i; R.b[i] = col_base; }
        sg_compute<4, 1>(F, XB, W, DM, R);
        const int t = F.tid >> 7, rr = (F.tid & 127) >> 2, cseg = F.tid & 3;
        float v[8]; sg_load8(F, t, rr, 8 * cseg, v);
        const int row = row_base + 32 * t + rr, col = col_base + 8 * cseg;
        if (col >= NZX) {
#pragma unroll
            for (int e = 0; e < 8; ++e) v[e] = softplus(v[e] + dt_bias[col - NZX + e]);
            float* d = DT + (size_t)row * 32 + (col - NZX);
            *(f32x4*)d = (f32x4){v[0], v[1], v[2], v[3]}; *(f32x4*)(d + 4) = (f32x4){v[4], v[5], v[6], v[7]};
        } else if (col < DIN) {
            *(GAS v4u*)(WSP(bf16, WS_Z) + (size_t)row * DIN + col) = pack8(v);
        } else {
            *(GAS v4u*)(WSP(bf16, WS_XBC) + (size_t)row * CONVD + (col - DIN)) = pack8(v);
            float* d = F.out + O_CONVS + ((size_t)(row - MP) * 3 + 2) * CONVD + (col - DIN);
            *(f32x4*)d = (f32x4){v[0], v[1], v[2], v[3]}; *(f32x4*)(d + 4) = (f32x4){v[4], v[5], v[6], v[7]};
        }
    }
}
__device__ __forceinline__ void p2_dt(Frame& F) {
    const bf16* XB = WSP(bf16, WS_XB); const bf16* W = WSP(bf16, WS_W0IN);
    float* DT = WSP(float, WS_DT); const float* dt_bias = F.in[10];
    for (int u = blockIdx.x; u < MP / 64; u += F.G) {
        SgRows R; R.a[0] = 64 * u; R.a[1] = 64 * u + 32; R.a[2] = 0; R.a[3] = 0; R.b[0] = NZX; R.b[1] = 0; R.b[2] = 0; R.b[3] = 0;
        sg_compute<2, 1>(F, XB, W, DM, R);
        const int t = F.tid >> 8, rr = (F.tid & 255) >> 3, c4 = (F.tid & 7) * 4;
        f32x4 v = *(const LAS f32x4*)((const LAS float*)(F.lds + RES_OFF) + t * 1024 + rr * 32 + c4);
        const f32x4 bb = *(const f32x4*)(dt_bias + c4);
#pragma unroll
        for (int e = 0; e < 4; ++e) v[e] = softplus(v[e] + bb[e]);
        *(f32x4*)(DT + (size_t)(64 * u + 32 * t + rr) * 32 + c4) = v;
    }
}
__device__ __forceinline__ void sample_outproj(Frame& F, const bf16* A, const bf16* Wt, const float* base, float* out, bf16* ob, float* ssq) {
    for (int u = blockIdx.x; u < 32; u += F.G) {
        const int i = u >> 3, q = u & 7; SgRows R;
#pragma unroll
        for (int j = 0; j < 4; ++j) { R.a[j] = MP + 32 * i; R.b[j] = 128 * q + 32 * j; }
        sg_compute<1, 4>(F, A, Wt, DIN, R);
        const int rr = F.tid >> 4, c8 = F.tid & 15;
        float v[8]; sg_load8(F, c8 >> 2, rr, 8 * (c8 & 3), v);
        const int bs = 32 * i + rr, col = 128 * q + 8 * c8;
        const f32x4 b0 = *(const f32x4*)(base + (size_t)bs * DM + col), b1 = *(const f32x4*)(base + (size_t)bs * DM + col + 4);
        float s = 0.f;
#pragma unroll
        for (int e = 0; e < 8; ++e) { v[e] += (e < 4 ? b0[e] : b1[e - 4]); s += v[e] * v[e]; }
        *(f32x4*)(out + (size_t)bs * DM + col) = (f32x4){v[0], v[1], v[2], v[3]}; *(f32x4*)(out + (size_t)bs * DM + col + 4) = (f32x4){v[4], v[5], v[6], v[7]};
        if (ob) *(GAS v4u*)(ob + (size_t)bs * DM + col) = pack8(v);
        s += __shfl_xor(s, 1); s += __shfl_xor(s, 2); s += __shfl_xor(s, 4); s += __shfl_xor(s, 8);
        if (c8 == 0) ssq[(size_t)(MP + bs) * 8 + q] = s;
    }
}
__device__ __forceinline__ void p6_small(Frame& F) {
    const bf16* X1B = WSP(bf16, WS_XB); const bf16* W = WSP(bf16, WS_W1IN); const float* ssq1 = WSP(float, WS_SSQ1);
    bf16* U = WSP(bf16, WS_Z); bf16* Gt = WSP(bf16, WS_XBCC);
    for (int u = blockIdx.x; u < 256; u += F.G) {
        const int i2 = u >> 7, pn = (u >> 2) & 31, wc = u & 3; SgRows R;
        R.a[0] = MP + 64 * i2; R.a[1] = MP + 64 * i2 + 32; R.a[2] = 0; R.a[3] = 0;
        R.b[0] = 256 * pn + 32 * wc; R.b[1] = 256 * pn + 128 + 32 * wc; R.b[2] = 0; R.b[3] = 0;
        sg_compute<2, 2>(F, X1B, W, DM, R);
        if (F.tid < 256) {
            const int i = F.tid >> 7, rr = (F.tid >> 2) & 31, cq = F.tid & 3;
            const LAS float* res = (const LAS float*)(F.lds + RES_OFF);
            const f32x4 bg = *(const LAS f32x4*)(res + (i * 2 + 0) * 1024 + rr * 32 + 4 * cq), cg = *(const LAS f32x4*)(res + (i * 2 + 0) * 1024 + rr * 32 + 16 + 4 * cq);
            const f32x4 xi = *(const LAS f32x4*)(res + (i * 2 + 1) * 1024 + rr * 32 + 4 * cq), zg = *(const LAS f32x4*)(res + (i * 2 + 1) * 1024 + rr * 32 + 16 + 4 * cq);
            const int bs = 64 * i2 + 32 * i + rr, row = MP + bs, ch = 64 * pn + 16 * wc + 4 * cq;
            const f32x4 q0 = *(const f32x4*)(ssq1 + (size_t)row * 8), q1 = *(const f32x4*)(ssq1 + (size_t)row * 8 + 4);
            const float rs = 1.0f / sqrtf(((q0[0] + q0[1]) + (q0[2] + q0[3]) + (q1[0] + q1[1]) + (q1[2] + q1[3])) * (1.0f / DM) + EPS);
            f32x4 uu, gg;
#pragma unroll
            for (int e = 0; e < 4; ++e) { uu[e] = (cg[e] * rs) * (xi[e] * rs); gg[e] = (bg[e] * rs) * silu(zg[e] * rs); }
            u32x2 wu, wg; wu.x = pkbf(uu[0], uu[1]); wu.y = pkbf(uu[2], uu[3]); wg.x = pkbf(gg[0], gg[1]); wg.y = pkbf(gg[2], gg[3]);
            *(GAS u32x2*)(U + (size_t)row * DSC + ch) = wu; *(GAS u32x2*)(Gt + (size_t)row * DSC + ch) = wg;
            *(f32x4*)(F.out + O_SCS + ((size_t)bs * 2 + 1) * DSC + ch) = uu;
        }
    }
}

__device__ __forceinline__ void p2_conv(Frame& F) {
    const bf16* XBC = WSP(bf16, WS_XBC); bf16* XC = WSP(bf16, WS_XBCC);
    const float* cw = F.in[8]; const float* cb = F.in[9];
    const int gt = F.vcu * (NWAVES * 64) + F.tid, NT = F.G * NWAVES * 64;
    constexpr int NCS = CONVD / 8, NP = (MP / 16) * NCS, NS = MS * NCS;
    for (int idx = gt; idx < NP + NS; idx += NT) {
        const bool smp = idx >= NP; const int id2 = smp ? idx - NP : idx;
        const int tb = id2 / NCS, c0 = (id2 % NCS) * 8;
        float w[4][8], bias[8];
#pragma unroll
        for (int k = 0; k < 4; ++k) { const f32x4 a = *(const f32x4*)(cw + k * CONVD + c0), b = *(const f32x4*)(cw + k * CONVD + c0 + 4);
#pragma unroll
            for (int e = 0; e < 4; ++e) { w[k][e] = a[e]; w[k][4 + e] = b[e]; } }
        { const f32x4 a = *(const f32x4*)(cb + c0), b = *(const f32x4*)(cb + c0 + 4);
#pragma unroll
            for (int e = 0; e < 4; ++e) { bias[e] = a[e]; bias[4 + e] = b[e]; } }
        float r0[8], r1[8], r2[8], cur[8], o[8];
        if (!smp) {
            const int tok0 = tb * 16;
            if ((tok0 & (SEQ - 1)) == 0) {
#pragma unroll
                for (int e = 0; e < 8; ++e) { r0[e] = 0.f; r1[e] = 0.f; r2[e] = 0.f; }
            } else {
                unpack8(*(const GAS v4u*)(XBC + (size_t)(tok0 - 3) * CONVD + c0), r0); unpack8(*(const GAS v4u*)(XBC + (size_t)(tok0 - 2) * CONVD + c0), r1); unpack8(*(const GAS v4u*)(XBC + (size_t)(tok0 - 1) * CONVD + c0), r2);
            }
#pragma unroll 4
            for (int t = 0; t < 16; ++t) {
                unpack8(*(const GAS v4u*)(XBC + (size_t)(tok0 + t) * CONVD + c0), cur);
#pragma unroll
                for (int e = 0; e < 8; ++e) { o[e] = silu(bias[e] + w[0][e] * r0[e] + w[1][e] * r1[e] + w[2][e] * r2[e] + w[3][e] * cur[e]); r0[e] = r1[e]; r1[e] = r2[e]; r2[e] = cur[e]; }
                *(GAS v4u*)(XC + (size_t)(tok0 + t) * CONVD + c0) = pack8(o);
            }
        } else {
            const int bs = tb; const float* st = F.in[3] + (size_t)bs * 3 * CONVD + c0; float* so = F.out + O_CONVS + (size_t)bs * 3 * CONVD + c0;
#pragma unroll
            for (int e = 0; e < 8; ++e) { r0[e] = st[e]; r1[e] = st[CONVD + e]; r2[e] = st[2 * CONVD + e]; }
            unpack8(*(const GAS v4u*)(XBC + (size_t)(MP + bs) * CONVD + c0), cur);
#pragma unroll
            for (int e = 0; e < 8; ++e) { o[e] = silu(bias[e] + w[0][e] * r0[e] + w[1][e] * r1[e] + w[2][e] * r2[e] + w[3][e] * cur[e]); so[e] = r1[e]; so[CONVD + e] = r2[e]; }
            *(GAS v4u*)(XC + (size_t)(MP + bs) * CONVD + c0) = pack8(o);
        }
    }
}

__device__ __forceinline__ int swz(int row, int col) { return row * 256 + ((((col >> 3) ^ (row & 15)) << 4) | ((col & 7) << 1)); }
__device__ __forceinline__ bf16x8 ldfrag(const LAS unsigned char* base, int row, int chunk) { return *(const LAS bf16x8*)(base + row * 256 + ((chunk ^ (row & 15)) << 4)); }
typedef short s16x4 __attribute__((ext_vector_type(4)));
__device__ __forceinline__ s16x4 trread(const LAS unsigned char* p) { return __builtin_bit_cast(s16x4, __builtin_amdgcn_ds_read_tr16_b64_v4i16((LAS s16x4*)p)); }
constexpr int PS128 = 272, PS64 = 144;
__device__ __forceinline__ bf16x8 ldfragp(const LAS unsigned char* lanebase, int off) { return *(const LAS bf16x8*)(lanebase + off); }
template <int STRIDE> __device__ __forceinline__ bf16x8 trfragp(const LAS unsigned char* trbase, int k0, int c0) {
    const s16x4 lo = trread(trbase + k0 * STRIDE + c0 * 2), hi = trread(trbase + (k0 + 4) * STRIDE + c0 * 2);
    return (bf16x8){lo[0], lo[1], lo[2], lo[3], hi[0], hi[1], hi[2], hi[3]};
}
__device__ __forceinline__ void p3_ssd(Frame& F) {
    constexpr int L_C = 0, L_B = 34816, L_M = 69632, L_XS = 104448, L_XW = 122880, L_H = 141312, L_SM = 158720;
    const int tid = F.tid, lane = F.lane, wid = F.wave, r32 = lane & 31, hh = lane >> 5;
    LAS unsigned char* L = F.lds; LAS float* sm = (LAS float*)(L + L_SM);
    const bf16* XC = WSP(bf16, WS_XBCC); const bf16* Zb = WSP(bf16, WS_Z); const float* DT = WSP(float, WS_DT);
    bf16* YG = WSP(bf16, WS_YG); float* SSQ = WSP(float, WS_SSQ);
    for (int item = F.vcu; item < NSEQ * NH; item += F.G) {
        const int b = item >> 5, h = item & 31, g = h >> 3;
        const float Ah = -__expf(F.in[11][h]), Dh = F.in[12][h];
        f32x16 HT;
#pragma unroll
        for (int e = 0; e < 16; ++e) HT[e] = 0.f;
        const int lt = wid >> 1, pt = wid & 1;
        const int st_a = wid < 4 ? 0 : (wid < 7 ? 1 : 2), lt_a = wid < 4 ? wid : (wid < 7 ? wid - 3 : 2);
        const int st_b = wid == 0 ? 2 : 3, lt_b = 3;
        const int xl = tid >> 2, xp0 = (tid & 3) * 16;
        const int rb128 = r32 * PS128 + hh * 16;
        const int tr128 = (8 * hh + ((lane >> 2) & 3)) * PS128 + (16 * ((lane >> 4) & 1) + 4 * (lane & 3)) * 2, tr64 = (8 * hh + ((lane >> 2) & 3)) * PS64 + (16 * ((lane >> 4) & 1) + 4 * (lane & 3)) * 2;
        v4u pc[4], pb[4], px[2], pz[2]; float pdt = 0.f, pdt0 = 0.f;
#define SSD_LOADCHUNK(T0) do { \
            _Pragma("unroll") for (int i = 0; i < 4; ++i) { const int q = tid + 512 * i, row = q >> 4, ch = q & 15; const bf16* src = XC + (size_t)((T0) + row) * CONVD; \
                pc[i] = *(const GAS v4u*)(src + 2560 + 128 * g + 8 * ch); pb[i] = *(const GAS v4u*)(src + 2048 + 128 * g + 8 * ch); } \
            px[0] = *(const GAS v4u*)(XC + (size_t)((T0) + xl) * CONVD + 64 * h + xp0); px[1] = *(const GAS v4u*)(XC + (size_t)((T0) + xl) * CONVD + 64 * h + xp0 + 8); \
            pz[0] = *(const GAS v4u*)(Zb + (size_t)((T0) + xl) * DIN + 64 * h + xp0); pz[1] = *(const GAS v4u*)(Zb + (size_t)((T0) + xl) * DIN + 64 * h + xp0 + 8); \
            if (wid < 2) { pdt = DT[(size_t)((T0) + tid) * 32 + h]; if (wid == 1) pdt0 = DT[(size_t)((T0) + lane) * 32 + h]; } } while (0)
        SSD_LOADCHUNK(b * SEQ);
        for (int c = 0; c < SEQ / 128; ++c) {
            const int t0 = b * SEQ + c * 128;
            const v4u cx0 = px[0], cx1 = px[1], cz0 = pz[0], cz1 = pz[1];
#pragma unroll
            for (int i = 0; i < 4; ++i) { const int q = tid + 512 * i, row = q >> 4, ch = q & 15;
                *(LAS v4u*)(L + L_C + row * PS128 + ch * 16) = pc[i]; *(LAS v4u*)(L + L_B + row * PS128 + ch * 16) = pb[i]; }
            *(LAS v4u*)(L + L_XS + xl * PS64 + xp0 * 2) = cx0; *(LAS v4u*)(L + L_XS + xl * PS64 + xp0 * 2 + 16) = cx1;
            if (wid < 2) {
                const float dtv = pdt; float v = dtv * Ah;
#pragma unroll
                for (int o = 1; o < 64; o <<= 1) { const float u = __shfl_up(v, o); if (lane >= o) v += u; }
                if (wid == 1) v += wave_sum(pdt0 * Ah);
                const float a2 = v * LOG2E;
                sm[tid] = a2; sm[128 + tid] = __log2f(dtv) - a2; sm[384 + tid] = __builtin_amdgcn_exp2f(a2); sm[512 + tid] = dtv;
            }
            if (c + 1 < SEQ / 128) SSD_LOADCHUNK(t0 + 128);
            LBAR();
            const float a2last = sm[127];
            { const float wsc = sm[512 + xl] * __builtin_amdgcn_exp2f(a2last - sm[xl]); float f[8];
                unpack8(cx0, f);
#pragma unroll
                for (int e = 0; e < 8; ++e) f[e] *= wsc;
                *(LAS v4u*)(L + L_XW + xl * PS64 + xp0 * 2) = pack8(f);
                unpack8(cx1, f);
#pragma unroll
                for (int e = 0; e < 8; ++e) f[e] *= wsc;
                *(LAS v4u*)(L + L_XW + xl * PS64 + xp0 * 2 + 16) = pack8(f); }
            f32x16 cba, cbb, Y;
#pragma unroll
            for (int e = 0; e < 16; ++e) { cba[e] = 0.f; cbb[e] = 0.f; Y[e] = 0.f; }
#pragma unroll
            for (int ks = 0; ks < 8; ++ks) cba = __builtin_amdgcn_mfma_f32_32x32x16_bf16(ldfragp(L + L_B + 32 * st_a * PS128 + rb128, 32 * ks), ldfragp(L + L_C + 32 * lt_a * PS128 + rb128, 32 * ks), cba, 0, 0, 0);
            if (wid < 2) {
#pragma unroll
                for (int ks = 0; ks < 8; ++ks) cbb = __builtin_amdgcn_mfma_f32_32x32x16_bf16(ldfragp(L + L_B + 32 * st_b * PS128 + rb128, 32 * ks), ldfragp(L + L_C + 32 * lt_b * PS128 + rb128, 32 * ks), cbb, 0, 0, 0);
            }
            if (c > 0) {
#pragma unroll
                for (int ks = 0; ks < 8; ++ks) Y = __builtin_amdgcn_mfma_f32_32x32x16_bf16(ldfragp(L + L_C + 32 * lt * PS128 + rb128, 32 * ks), ldfragp(L + L_H + 32 * pt * PS128 + rb128, 32 * ks), Y, 0, 0, 0);
#pragma unroll
                for (int e = 0; e < 16; ++e) Y[e] *= sm[384 + 32 * lt + (e & 3) + 8 * (e >> 2) + 4 * hh];
            }
            {
                const int l = 32 * lt_a + r32; const float a2l = sm[l];
#pragma unroll
                for (int q4 = 0; q4 < 4; ++q4) { const int s0 = 32 * st_a + 8 * q4 + 4 * hh; float m[4];
#pragma unroll
                    for (int e = 0; e < 4; ++e) { const int s2 = s0 + e; m[e] = (s2 <= l) ? cba[4 * q4 + e] * __builtin_amdgcn_exp2f(a2l + sm[128 + s2]) : 0.f; }
                    u32x2 w; w.x = pkbf(m[0], m[1]); w.y = pkbf(m[2], m[3]); *(LAS u32x2*)(L + L_M + l * PS128 + s0 * 2) = w; }
            }
            if (wid < 2) {
                const int l = 32 * lt_b + r32; const float a2l = sm[l];
#pragma unroll
                for (int q4 = 0; q4 < 4; ++q4) { const int s0 = 32 * st_b + 8 * q4 + 4 * hh; float m[4];
#pragma unroll
                    for (int e = 0; e < 4; ++e) { const int s2 = s0 + e; m[e] = (s2 <= l) ? cbb[4 * q4 + e] * __builtin_amdgcn_exp2f(a2l + sm[128 + s2]) : 0.f; }
                    u32x2 w; w.x = pkbf(m[0], m[1]); w.y = pkbf(m[2], m[3]); *(LAS u32x2*)(L + L_M + l * PS128 + s0 * 2) = w; }
            }
            LBAR();
            for (int s2 = 0; s2 <= lt; ++s2) {
#pragma unroll
                for (int k2 = 0; k2 < 2; ++k2) Y = __builtin_amdgcn_mfma_f32_32x32x16_bf16(ldfragp(L + L_M + 32 * lt * PS128 + rb128 + 64 * s2, 32 * k2), trfragp<PS64>(L + L_XS + tr64 + 32 * s2 * PS64, 16 * k2, 32 * pt), Y, 0, 0, 0);
            }
            { const float el = __builtin_amdgcn_exp2f(a2last);
#pragma unroll
                for (int e = 0; e < 16; ++e) HT[e] *= el; }
#pragma unroll
            for (int ks = 0; ks < 8; ++ks) HT = __builtin_amdgcn_mfma_f32_32x32x16_bf16(trfragp<PS128>(L + L_B + tr128 + 64 * lt, 16 * ks, 0), trfragp<PS64>(L + L_XW + tr64 + 64 * pt, 16 * ks, 0), HT, 0, 0, 0);
            LBAR();
#pragma unroll
            for (int e = 0; e < 16; ++e) { const int l = 32 * lt + (e & 3) + 8 * (e >> 2) + 4 * hh; *(LAS float*)(L + L_M + (l * 64 + 32 * pt + r32) * 4) = Y[e]; }
#pragma unroll
            for (int q4 = 0; q4 < 4; ++q4) { u32x2 w; w.x = pkbf(HT[4 * q4], HT[4 * q4 + 1]); w.y = pkbf(HT[4 * q4 + 2], HT[4 * q4 + 3]);
                *(LAS u32x2*)(L + L_H + (32 * pt + r32) * PS128 + (32 * lt + 8 * q4 + 4 * hh) * 2) = w; }
            LBAR();
            {
                const size_t tok = (size_t)(t0 + xl);
                float y[16], xf[16], zf[16];
#pragma unroll
                for (int q4 = 0; q4 < 4; ++q4) { const f32x4 a = *(const LAS f32x4*)(L + L_M + (xl * 64 + xp0 + 4 * q4) * 4); y[4 * q4] = a[0]; y[4 * q4 + 1] = a[1]; y[4 * q4 + 2] = a[2]; y[4 * q4 + 3] = a[3]; }
                { float t8[8]; unpack8(cx0, t8);
#pragma unroll
                    for (int e = 0; e < 8; ++e) xf[e] = t8[e];
                    unpack8(cx1, t8);
#pragma unroll
                    for (int e = 0; e < 8; ++e) xf[8 + e] = t8[e];
                    unpack8(cz0, t8);
#pragma unroll
                    for (int e = 0; e < 8; ++e) zf[e] = t8[e];
                    unpack8(cz1, t8);
#pragma unroll
                    for (int e = 0; e < 8; ++e) zf[8 + e] = t8[e]; }
                float ss = 0.f; float o0[8], o1[8];
#pragma unroll
                for (int e = 0; e < 16; ++e) { const float v = (y[e] + Dh * xf[e]) * silu(zf[e]); ss += v * v; if (e < 8) o0[e] = v; else o1[e - 8] = v; }
                *(GAS v4u*)(YG + tok * DIN + 64 * h + xp0) = pack8(o0); *(GAS v4u*)(YG + tok * DIN + 64 * h + xp0 + 8) = pack8(o1);
                ss += __shfl_xor(ss, 1); ss += __shfl_xor(ss, 2);
                if ((tid & 3) == 0) SSQ[tok * 32 + h] = ss;
            }
            LBAR();
        }
#undef SSD_LOADCHUNK
        float* hp = F.out + O_SSMP + (size_t)(b * NH + h) * 64 * DS;
#pragma unroll
        for (int e = 0; e < 16; ++e) { const int n = 32 * lt + (e & 3) + 8 * (e >> 2) + 4 * hh; hp[(32 * pt + r32) * DS + n] = HT[e]; }
    }
}
__device__ __forceinline__ void p3_sample(Frame& F) {
    const int lane = F.lane, wid = F.wave, r32 = lane & 31, hh = lane >> 5;
    const bf16* XC = WSP(bf16, WS_XBCC); const bf16* Zb = WSP(bf16, WS_Z); const float* DT = WSP(float, WS_DT);
    bf16* YG = WSP(bf16, WS_YG); float* SSQ = WSP(float, WS_SSQ);
    LAS float* ys = (LAS float*)(F.lds + 4096) + wid * 64;
    for (int item = F.vcu * NWAVES + wid; item < MS * NH; item += F.G * NWAVES) {
        const int bs = item >> 5, h = item & 31, g = h >> 3; const size_t row = (size_t)(MP + bs);
        const float dtv = DT[row * 32 + h], dA = __expf(dtv * -__expf(F.in[11][h])), Dh = F.in[12][h];
        const float xv = bf2f(XC[row * CONVD + 64 * h + lane]);
        const u32x2 bw = *(const GAS u32x2*)(XC + row * CONVD + 2048 + 128 * g + 4 * r32), cw = *(const GAS u32x2*)(XC + row * CONVD + 2560 + 128 * g + 4 * r32);
        const f32x4 B4 = {bflo(bw.x), bfhi(bw.x), bflo(bw.y), bfhi(bw.y)}, C4 = {bflo(cw.x), bfhi(cw.x), bflo(cw.y), bfhi(cw.y)};
        const float* hin = F.in[2] + ((size_t)bs * NH + h) * 64 * DS; float* hout = F.out + O_SSMS + ((size_t)bs * NH + h) * 64 * DS;
#pragma unroll 8
        for (int it = 0; it < 32; ++it) {
            const int p = 2 * it + hh; const float xp = __shfl(xv, p) * dtv;
            const f32x4 hv = *(const GAS f32x4*)(hin + p * DS + 4 * r32);
            const f32x4 hn = hv * dA + B4 * xp;
            *(GAS f32x4*)(hout + p * DS + 4 * r32) = hn;
            float part = (hn[0] * C4[0] + hn[1] * C4[1]) + (hn[2] * C4[2] + hn[3] * C4[3]);
            part += __shfl_xor(part, 1); part += __shfl_xor(part, 2); part += __shfl_xor(part, 4); part += __shfl_xor(part, 8); part += __shfl_xor(part, 16);
            if (r32 == 0) ys[p] = part;
        }
        LDS_WAIT(); asm volatile("" ::: "memory");
        const float yv = ys[lane];
        const float z = bf2f(Zb[row * DIN + 64 * h + lane]);
        const float yg = (yv + Dh * xv) * silu(z);
        const float s = wave_sum(yg * yg);
        YG[row * DIN + 64 * h + lane] = (bf16)f2bf(yg);
        if (lane == 0) SSQ[row * 32 + h] = s;
        LDS_WAIT(); asm volatile("" ::: "memory");
    }
}

__device__ __forceinline__ void p4_gnorm(Frame& F) {
    const bf16* YG = WSP(bf16, WS_YG); const float* SSQ = WSP(float, WS_SSQ); bf16* YN = WSP(bf16, WS_XBC);
    const int gt = F.vcu * (NWAVES * 64) + F.tid, NT = F.G * NWAVES * 64;
    for (int idx = gt; idx < MT * (DIN / 8); idx += NT) {
        const int row = idx >> 8, c0 = (idx & 255) * 8, g = c0 >> 9;
        const f32x4 q0 = *(const f32x4*)(SSQ + (size_t)row * 32 + 8 * g), q1 = *(const f32x4*)(SSQ + (size_t)row * 32 + 8 * g + 4);
        const float rs = 1.0f / sqrtf(((q0[0] + q0[1]) + (q0[2] + q0[3]) + (q1[0] + q1[1]) + (q1[2] + q1[3])) * (1.0f / 512.0f) + EPS);
        float f[8]; unpack8(*(const GAS v4u*)(YG + (size_t)row * DIN + c0), f);
#pragma unroll
        for (int e = 0; e < 8; ++e) f[e] *= rs;
        *(GAS v4u*)(YN + (size_t)row * DIN + c0) = pack8(f);
    }
}
__device__ __forceinline__ void p7_scconv(Frame& F) {
    const bf16* U = WSP(bf16, WS_Z); bf16* Gt = WSP(bf16, WS_XBCC); const float* cw = F.in[16];
    const int gt = F.vcu * (NWAVES * 64) + F.tid, NT = F.G * NWAVES * 64;
    constexpr int NCS = DSC / 8, NP = (MP / 16) * NCS, NS = MS * NCS;
    for (int idx = gt; idx < NP + NS; idx += NT) {
        const bool smp = idx >= NP; const int id2 = smp ? idx - NP : idx;
        const int tb = id2 / NCS, c0 = (id2 % NCS) * 8;
        float w[3][8];
#pragma unroll
        for (int k = 0; k < 3; ++k) { const f32x4 a = *(const f32x4*)(cw + k * DSC + c0), b = *(const f32x4*)(cw + k * DSC + c0 + 4);
#pragma unroll
            for (int e = 0; e < 4; ++e) { w[k][e] = a[e]; w[k][4 + e] = b[e]; } }
        float r0[8], r1[8], cur[8], gv[8], o[8];
        if (!smp) {
            const int tok0 = tb * 16, pos0 = tok0 & (SEQ - 1);
            if (pos0 == 0) {
#pragma unroll
                for (int e = 0; e < 8; ++e) { r0[e] = 0.f; r1[e] = 0.f; }
            } else { unpack8(*(const GAS v4u*)(U + (size_t)(tok0 - 2) * DSC + c0), r0); unpack8(*(const GAS v4u*)(U + (size_t)(tok0 - 1) * DSC + c0), r1); }
#pragma unroll 4
            for (int t = 0; t < 16; ++t) {
                unpack8(*(const GAS v4u*)(U + (size_t)(tok0 + t) * DSC + c0), cur); unpack8(*(const GAS v4u*)(Gt + (size_t)(tok0 + t) * DSC + c0), gv);
#pragma unroll
                for (int e = 0; e < 8; ++e) { o[e] = gv[e] * (w[0][e] * r0[e] + w[1][e] * r1[e] + w[2][e] * cur[e]); r0[e] = r1[e]; r1[e] = cur[e]; }
                *(GAS v4u*)(Gt + (size_t)(tok0 + t) * DSC + c0) = pack8(o);
            }
            if (pos0 == SEQ - 16) { float* d = F.out + O_SCP + (size_t)(tok0 >> 11) * 2 * DSC + c0;
#pragma unroll
                for (int e = 0; e < 8; ++e) { d[e] = r0[e]; d[DSC + e] = r1[e]; } }
        } else {
            const int bs = tb; const float* st = F.in[4] + (size_t)bs * 2 * DSC + c0;
#pragma unroll
            for (int e = 0; e < 8; ++e) { r0[e] = st[e]; r1[e] = st[DSC + e]; }
            unpack8(*(const GAS v4u*)(U + (size_t)(MP + bs) * DSC + c0), cur); unpack8(*(const GAS v4u*)(Gt + (size_t)(MP + bs) * DSC + c0), gv);
            float* so = F.out + O_SCS + (size_t)bs * 2 * DSC + c0;
#pragma unroll
            for (int e = 0; e < 8; ++e) { o[e] = gv[e] * (w[0][e] * r0[e] + w[1][e] * r1[e] + w[2][e] * cur[e]); so[e] = r1[e]; }
            *(GAS v4u*)(Gt + (size_t)(MP + bs) * DSC + c0) = pack8(o);
        }
    }
}
__device__ __forceinline__ void p9_final(Frame& F) {
    const float* ssq2 = WSP(float, WS_SSQ2); const float* fw = F.in[6];
    const int gw = F.vcu * NWAVES + F.wave, NGW = F.G * NWAVES;
    f32x4 wv[4];
#pragma unroll
    for (int j = 0; j < 4; ++j) wv[j] = *((const GAS f32x4*)fw + F.lane + 64 * j);
    for (int m = gw; m < MT; m += NGW) {
        float* rowp = m < MP ? F.out + O_YP + (size_t)m * DM : F.out + O_YS + (size_t)(m - MP) * DM;
        const f32x4 q0 = *(const f32x4*)(ssq2 + (size_t)m * 8), q1 = *(const f32x4*)(ssq2 + (size_t)m * 8 + 4);
        const float rs = 1.0f / sqrtf(((q0[0] + q0[1]) + (q0[2] + q0[3]) + (q1[0] + q1[1]) + (q1[2] + q1[3])) * (1.0f / DM) + EPS);
        GAS f32x4* xr = (GAS f32x4*)rowp + F.lane;
#pragma unroll
        for (int j = 0; j < 4; ++j) { const f32x4 v = xr[64 * j]; xr[64 * j] = v * rs * wv[j]; }
    }
}

#ifndef PROBE_DUP
#define PROBE_DUP 0
#endif
constexpr int N_PHASES = 10;
struct Args { const float* in[18]; float* out; unsigned char* ws; int ph_lo, ph_hi, li, pad; };
__global__ void __launch_bounds__(NWAVES * 64, 2) hyb_fwd(Args args) {
    extern __shared__ __attribute__((aligned(16))) unsigned char lds[];
    Frame F;
    F.lds = (LAS unsigned char*)lds;
    F.tid = threadIdx.x; F.lane = F.tid & 63; F.wave = __builtin_amdgcn_readfirstlane(F.tid >> 6);
    F.G = gridDim.x; { const int bx = blockIdx.x; F.vcu = (F.G % 8 == 0) ? (bx % 8) * (F.G / 8) + bx / 8 : bx; }
#pragma unroll
    for (int i = 0; i < 18; ++i) F.in[i] = args.in[i];
    F.out = args.out; F.ws = args.ws;
    volatile LAS unsigned* MISC = (volatile LAS unsigned*)(F.lds + MISC_OFF);
    for (int u = F.tid; u < (LDS_BYTES - MISC_OFF) / 4; u += NWAVES * 64) ((LAS unsigned*)(F.lds + MISC_OFF))[u] = 0u;
    __syncthreads();
    const int lo = args.ph_lo, hi = args.ph_hi;
    const bool multi = (hi - lo) > 1;
    XcdBarrier bar; bar.bar = (unsigned*)(F.ws + WS_CTL) + CW_BAR + args.li * XCD_BAR_WORDS; bar.x = 0; bar.st = nullptr;
    if (multi) bar = xcd_barrier_post((unsigned*)(F.ws + WS_CTL) + CW_BAR + args.li * XCD_BAR_WORDS, MISC + 8);
#define IN(k) (lo <= (k) && (k) < hi)
#define SEAM(k) do { if (IN(k) && IN((k) + 1)) xcd_barrier(bar); } while (0)
    LAS unsigned char* ring = (LAS unsigned char*)F.lds;
    if (IN(0)) { p0_prologue(F); } SEAM(0);
    if (IN(1)) {
        pg8::Gemm g{WSP(pg8::bf16_t, WS_XB), WSP(pg8::bf16_t, WS_W0IN), MP, NZX, DM}; pg8::StaticOrder S; S.init(MP, NZX, F.G, (int)blockIdx.x);
        pg8::EpiInSsd E{WSP(pg8::bf16_t, WS_Z), WSP(pg8::bf16_t, WS_XBC), F.out + O_CONVP};
        for (int rep = 0; rep < (PROBE_DUP == 1 ? args.li + 2 : 1); ++rep) pg8::gemm_phase<pg8::EpiInSsd, pg8::StaticOrder, true, true>(ring, g, S, E);
        for (int rep = 0; rep < (PROBE_DUP == 11 ? args.li + 2 : 1); ++rep) p1_small(F);
    } SEAM(1);
    if (IN(2)) { p2_dt(F); p2_conv(F); } SEAM(2);
    if (IN(3)) { for (int rep = 0; rep < (PROBE_DUP == 3 ? args.li + 2 : 1); ++rep) p3_ssd(F);
        for (int rep = 0; rep < (PROBE_DUP == 31 ? args.li + 2 : 1); ++rep) p3_sample(F);
    } SEAM(3);
    if (IN(4)) { p4_gnorm(F); } SEAM(4);
    if (IN(5)) {
        pg8::Gemm g{WSP(pg8::bf16_t, WS_XBC), WSP(pg8::bf16_t, WS_W0OUT), MP, DM, DIN}; pg8::StaticOrder S; S.init(MP, DM, F.G, (int)blockIdx.x);
        pg8::EpiResid<true> E{F.in[0], WSP(float, WS_X1), WSP(pg8::bf16_t, WS_XB), WSP(float, WS_SSQ1)};
        pg8::gemm_phase<pg8::EpiResid<true>, pg8::StaticOrder, false, true>(ring, g, S, E);
        for (int rep = 0; rep < (PROBE_DUP == 51 ? args.li + 2 : 1); ++rep) sample_outproj(F, WSP(bf16, WS_XBC), WSP(bf16, WS_W0OUT), F.in[1], WSP(float, WS_X1) + (size_t)MP * DM, WSP(bf16, WS_XB) + (size_t)MP * DM, WSP(float, WS_SSQ1));
    } SEAM(5);
    if (IN(6)) {
        pg8::Gemm g{WSP(pg8::bf16_t, WS_XB), WSP(pg8::bf16_t, WS_W1IN), MP, NIN1, DM}; pg8::StaticOrder S; S.init(MP, NIN1, F.G, (int)blockIdx.x);
        pg8::EpiInSc E{WSP(pg8::bf16_t, WS_Z), WSP(pg8::bf16_t, WS_XBCC), WSP(float, WS_SSQ1)};
        for (int rep = 0; rep < (PROBE_DUP == 6 ? args.li + 2 : 1); ++rep) pg8::gemm_phase<pg8::EpiInSc, pg8::StaticOrder, true, true>(ring, g, S, E);
        for (int rep = 0; rep < (PROBE_DUP == 61 ? args.li + 2 : 1); ++rep) p6_small(F);
    } SEAM(6);
    if (IN(7)) { p7_scconv(F); } SEAM(7);
    if (IN(8)) {
        pg8::Gemm g{WSP(pg8::bf16_t, WS_XBCC), WSP(pg8::bf16_t, WS_W1OUT), MP, DM, DSC}; pg8::StaticOrder S; S.init(MP, DM, F.G, (int)blockIdx.x);
        pg8::EpiResid<false> E{WSP(float, WS_X1), F.out + O_YP, nullptr, WSP(float, WS_SSQ2)};
        pg8::gemm_phase<pg8::EpiResid<false>, pg8::StaticOrder, false, true>(ring, g, S, E);
        sample_outproj(F, WSP(bf16, WS_XBCC), WSP(bf16, WS_W1OUT), WSP(float, WS_X1) + (size_t)MP * DM, F.out + O_YS, nullptr, WSP(float, WS_SSQ2));
    } SEAM(8);
    if (IN(9)) { p9_final(F); }
#undef IN
#undef SEAM
}

#ifndef HYB_N_LAUNCHES
#define HYB_N_LAUNCHES 1
#endif
extern "C" void kernel_launch(void* const* d_in, const int* in_sizes, int n_in, void* d_out, int out_size, void* d_ws, size_t ws_size, hipStream_t stream) {
    static int grid = 0;
    if (grid == 0) {
        if (n_in != 18 || in_sizes[0] != MP * DM || out_size != (int)O_END || ws_size < WS_END) { fprintf(stderr, "kernel_launch: unexpected shapes: n_in %d in0 %d out %d ws %zu\n", n_in, n_in > 0 ? in_sizes[0] : -1, out_size, ws_size); grid = -1; return; }
        int dev = 0, cus = 0, per_cu = 0;
        if (hipGetDevice(&dev) != hipSuccess || hipDeviceGetAttribute(&cus, hipDeviceAttributeMultiprocessorCount, dev) != hipSuccess) { grid = -1; return; }
        if (hipFuncSetAttribute((const void*)hyb_fwd, hipFuncAttributeMaxDynamicSharedMemorySize, LDS_BYTES) != hipSuccess) { fprintf(stderr, "kernel_launch: hipFuncSetAttribute failed\n"); grid = -1; return; }
        if (hipOccupancyMaxActiveBlocksPerMultiprocessor(&per_cu, (const void*)hyb_fwd, NWAVES * 64, LDS_BYTES) != hipSuccess || per_cu < 1) fprintf(stderr, "kernel_launch: occupancy query reports %d blocks per CU\n", per_cu);
        (void)hipGetLastError();
        grid = cus;
    }
    if (grid < 0) return;
    if (hipMemsetAsync((char*)d_ws + WS_CTL, 0, CTL_ZERO_BYTES, stream) != hipSuccess) { fprintf(stderr, "kernel_launch: memset failed\n"); return; }
    Args a{};
    for (int i = 0; i < 18; ++i) a.in[i] = (const float*)d_in[i];
    a.out = (float*)d_out; a.ws = (unsigned char*)d_ws;
#if defined(PROBE_RELAUNCH)
    { const int k = PROBE_RELAUNCH; const int cuts[4][2] = {{0, k + 1}, {k, k + 1}, {k + 1, N_PHASES}, {0, 0}};
      for (int l = 0; l < 3; ++l) { if (cuts[l][0] >= cuts[l][1]) continue; a.ph_lo = cuts[l][0]; a.ph_hi = cuts[l][1]; a.li = l; hipLaunchKernelGGL(hyb_fwd, dim3(grid), dim3(NWAVES * 64), LDS_BYTES, stream, a); } }
#else
    if (HYB_N_LAUNCHES == 1) { a.ph_lo = 0; a.ph_hi = N_PHASES; a.li = 0; hipLaunchKernelGGL(hyb_fwd, dim3(grid), dim3(NWAVES * 64), LDS_BYTES, stream, a); }
    else for (int p = 0; p < N_PHASES; ++p) { a.ph_lo = p; a.ph_hi = p + 1; a.li = p; hipLaunchKernelGGL(hyb_fwd, dim3(grid), dim3(NWAVES * 64), LDS_BYTES, stream, a); }
#endif
    const hipError_t le = hipPeekAtLastError();
    if (le != hipSuccess) fprintf(stderr, "kernel_launch: launch failed: %s\n", hipGetErrorName(le));
}
```
